# Optimizing an MI355X kernel written in HIP

```python
import math
import jax, jax.numpy as jnp
from jax import lax
import numpy as np

D_MODEL = 2048
BATCH = 2
SEQ = 8192
DEPTH = 4

N_MIXERS = 3
HEAD_DIM = 128
A_Q_HEADS = D_MODEL // HEAD_DIM
A_KV_HEADS = 4
A_BRANCHES = ((128, 1), (512, 4), (2048, 16))
A_SEQ_MULT = max(w for w, _ in A_BRANCHES)
A_QKV_WIDTH = D_MODEL + len(A_BRANCHES) * 2 * A_KV_HEADS * HEAD_DIM
B_HEADS = D_MODEL // (2 * HEAD_DIM)
B_QBLOCK = 128
C_CONV_WIDTH = 3
D_FF = ((8 * D_MODEL // 3 + 255) // 256) * 256
PLE_DIM = 256
N_A = (DEPTH + 2) // 3
N_B = (DEPTH + 1) // 3
N_C = DEPTH // 3
RMS_EPS = 1e-6
SUBLN_EPS = 1e-5

kernel_name = "hybrid_dilated_diffattn_shortconv_macaron"


def rmsnorm(x, g, eps=RMS_EPS):
    xf = x.astype(jnp.float32)
    y = xf * lax.rsqrt(jnp.mean(xf * xf, axis=-1, keepdims=True) + eps)
    return (y * g.astype(jnp.float32)).astype(x.dtype)


def swiglu(h, w_in, w_out):
    gate, up = jnp.split(h @ w_in, 2, axis=-1)
    return (jax.nn.silu(gate) * up) @ w_out


def _to_residues(t, d):
    b, sp = t.shape[:2]
    rest = t.shape[2:]
    t = t.reshape((b, sp // d, d) + rest)
    t = jnp.moveaxis(t, 2, 1)
    return t.reshape((b * d, sp // d) + rest)


def _from_residues(t, b, d):
    n, l = t.shape[:2]
    rest = t.shape[2:]
    t = t.reshape((b, d, l) + rest)
    t = jnp.moveaxis(t, 1, 2)
    return t.reshape((b, l * d) + rest)


def _banded_causal_attention(q, k, v, block):
    n, length, hq, hd = q.shape
    hkv = k.shape[2]
    g = hq // hkv
    nb = length // block
    qb = q.reshape(n, nb, block, hkv, g, hd)

    def with_prev(t):
        tb = t.reshape(n, nb, block, hkv, hd)
        prev = jnp.pad(tb, ((0, 0), (1, 0), (0, 0), (0, 0), (0, 0)))[:, :nb]
        return jnp.concatenate([prev, tb], axis=2)

    kk = with_prev(k)
    vv = with_prev(v)
    s = jnp.einsum('nbqhgd,nbkhd->nbhgqk', qb, kk).astype(jnp.float32) * (hd ** -0.5)
    qi = jnp.arange(block)[:, None] + block
    kj = jnp.arange(2 * block)[None, :]
    dist = qi - kj
    band = (dist >= 0) & (dist <= block)
    first = jnp.arange(nb)[:, None, None] == 0
    mask = band[None] & ~(first & (kj < block)[None])
    s = jnp.where(mask[None, :, None, None], s, -jnp.inf)
    m = jnp.max(s, axis=-1)
    pr = jnp.exp(s - m[..., None])
    l = jnp.sum(pr, axis=-1)
    acc = jnp.einsum('nbhgqk,nbkhd->nbqhgd', pr.astype(v.dtype), vv).astype(jnp.float32)
    m = m.transpose(0, 1, 4, 2, 3).reshape(n, length, hq)
    l = l.transpose(0, 1, 4, 2, 3).reshape(n, length, hq)
    acc = acc.reshape(n, length, hq, hd)
    return m, l, acc


def dilated_sliding_window_attention(h, w_qkv, w_o):
    b, s, _ = h.shape
    sp = -(-s // A_SEQ_MULT) * A_SEQ_MULT
    qkv = jnp.pad(h @ w_qkv, ((0, 0), (0, sp - s), (0, 0)))
    q = qkv[..., :D_MODEL].reshape(b, sp, A_Q_HEADS, HEAD_DIM)
    kv = qkv[..., D_MODEL:].reshape(b, sp, len(A_BRANCHES), 2, A_KV_HEADS, HEAD_DIM)
    ms, ls, accs = [], [], []
    for gi, (window, dil) in enumerate(A_BRANCHES):
        m, l, acc = _banded_causal_attention(
            _to_residues(q, dil), _to_residues(kv[:, :, gi, 0], dil),
            _to_residues(kv[:, :, gi, 1], dil), window // dil)
        ms.append(_from_residues(m, b, dil)[:, :s])
        ls.append(_from_residues(l, b, dil)[:, :s])
        accs.append(_from_residues(acc, b, dil)[:, :s])
    m = jnp.stack(ms)
    l = jnp.stack(ls)
    acc = jnp.stack(accs)
    wgt = jnp.exp(m - jnp.max(m, axis=0, keepdims=True))
    out = jnp.sum(wgt[..., None] * acc, axis=0) / jnp.sum(wgt * l, axis=0)[..., None]
    return out.reshape(b, s, D_MODEL).astype(h.dtype) @ w_o


def differential_attention(h, w_qkv, w_o, lam_params, subln_g, lambda_init):
    b, s, _ = h.shape
    nb = s // B_QBLOCK
    qkv = h @ w_qkv
    q = qkv[..., :D_MODEL].reshape(b, s, B_HEADS, 2, HEAD_DIM)
    k = qkv[..., D_MODEL:2 * D_MODEL].reshape(b, s, B_HEADS, 2, HEAD_DIM)
    v = qkv[..., 2 * D_MODEL:].reshape(b, s, B_HEADS, 2 * HEAD_DIM)
    lp = lam_params.astype(jnp.float32)
    lam = jnp.exp(jnp.sum(lp[0] * lp[1])) - jnp.exp(jnp.sum(lp[2] * lp[3])) + lambda_init
    qb = q.reshape(b, nb, B_QBLOCK, B_HEADS, 2, HEAD_DIM).transpose(1, 0, 3, 4, 2, 5)
    kt = k.transpose(0, 2, 3, 1, 4)
    vt = v.transpose(0, 2, 1, 3)
    kpos = jnp.arange(s)
    scale = HEAD_DIM ** -0.5

    def attend_block(args):
        qblk, bi = args
        sc = jnp.einsum('bhcqd,bhckd->bhcqk', qblk, kt).astype(jnp.float32) * scale
        qpos = bi * B_QBLOCK + jnp.arange(B_QBLOCK)
        sc = jnp.where(kpos[None, :] <= qpos[:, None], sc, -jnp.inf)
        a = jax.nn.softmax(sc, axis=-1)
        diff = a[:, :, 0] - lam * a[:, :, 1]
        return jnp.einsum('bhqk,bhkd->bhqd', diff.astype(vt.dtype), vt)

    o = lax.map(attend_block, (qb, jnp.arange(nb)))
    o = o.transpose(1, 0, 3, 2, 4).reshape(b, s, B_HEADS, 2 * HEAD_DIM)
    o = rmsnorm(o, subln_g, SUBLN_EPS) * (1.0 - lambda_init)
    return o.reshape(b, s, D_MODEL) @ w_o


def short_gated_conv(h, w_in, conv_w, w_out):
    bg, cg, u = jnp.split(h @ w_in, 3, axis=-1)
    z = cg * u
    conv = lax.conv_general_dilated(
        z, conv_w[:, None, :].astype(z.dtype), window_strides=(1,),
        padding=((C_CONV_WIDTH - 1, 0),), dimension_numbers=('NWC', 'WIO', 'NWC'),
        feature_group_count=D_MODEL)
    return (bg * conv) @ w_out


def setup_inputs(seed: int = 0) -> dict:
    key = jax.random.key(seed)
    ks = jax.random.split(key, 32)

    def nrm(k, shape, scale):
        return jax.random.normal(k, shape, jnp.float32) * scale

    def gain(k, shape):
        return 1.0 + 0.02 * jax.random.normal(k, shape, jnp.float32)

    D, F = D_MODEL, D_FF
    return {
        "x": nrm(ks[0], (BATCH, SEQ, D), 1.0),
        "p": nrm(ks[1], (DEPTH, BATCH, SEQ, PLE_DIM), 1.0),
        "norm_ffn1": gain(ks[2], (DEPTH, D)),
        "w_ffn1_in": nrm(ks[3], (DEPTH, D, 2 * F), D ** -0.5),
        "w_ffn1_out": nrm(ks[4], (DEPTH, F, D), F ** -0.5),
        "norm_mix": gain(ks[5], (DEPTH, D)),
        "a_w_qkv": nrm(ks[6], (N_A, D, A_QKV_WIDTH), D ** -0.5),
        "a_w_o": nrm(ks[7], (N_A, D, D), D ** -0.5),
        "b_w_qkv": nrm(ks[8], (N_B, D, 3 * D), D ** -0.5),
        "b_w_o": nrm(ks[9], (N_B, D, D), D ** -0.5),
        "b_lambda": nrm(ks[10], (N_B, 4, HEAD_DIM), 0.1),
        "b_subln": gain(ks[11], (N_B, 2 * HEAD_DIM)),
        "c_w_in": nrm(ks[12], (N_C, D, 3 * D), D ** -0.5),
        "c_conv_w": nrm(ks[13], (N_C, C_CONV_WIDTH, D), C_CONV_WIDTH ** -0.5),
        "c_w_out": nrm(ks[14], (N_C, D, D), D ** -0.5),
        "norm_ffn2": gain(ks[15], (DEPTH, D)),
        "w_ffn2_in": nrm(ks[16], (DEPTH, D, 2 * F), D ** -0.5),
        "w_ffn2_out": nrm(ks[17], (DEPTH, F, D), F ** -0.5),
        "norm_ple": gain(ks[18], (DEPTH, D)),
        "w_ple_gate": nrm(ks[19], (DEPTH, D, D), D ** -0.5),
        "b_ple_gate": nrm(ks[20], (DEPTH, D), 0.02),
        "w_ple_proj": nrm(ks[21], (DEPTH, PLE_DIM, D), PLE_DIM ** -0.5),
        "norm_f": gain(ks[22], (D,)),
    }


def reference(x, p, norm_ffn1, w_ffn1_in, w_ffn1_out, norm_mix, a_w_qkv, a_w_o,
              b_w_qkv, b_w_o, b_lambda, b_subln, c_w_in, c_conv_w, c_w_out,
              norm_ffn2, w_ffn2_in, w_ffn2_out, norm_ple, w_ple_gate, b_ple_gate,
              w_ple_proj, norm_f):
    h = x
    for i in range(DEPTH):
        h = h + 0.5 * swiglu(rmsnorm(h, norm_ffn1[i]), w_ffn1_in[i], w_ffn1_out[i])
        hn = rmsnorm(h, norm_mix[i])
        kind, j = i % N_MIXERS, i // N_MIXERS
        if kind == 0:
            mix = dilated_sliding_window_attention(hn, a_w_qkv[j], a_w_o[j])
        elif kind == 1:
            lambda_init = 0.8 - 0.6 * math.exp(-0.3 * i)
            mix = differential_attention(hn, b_w_qkv[j], b_w_o[j], b_lambda[j],
                                         b_subln[j], lambda_init)
        else:
            mix = short_gated_conv(hn, c_w_in[j], c_conv_w[j], c_w_out[j])
        h = h + mix
        h = h + 0.5 * swiglu(rmsnorm(h, norm_ffn2[i]), w_ffn2_in[i], w_ffn2_out[i])
        gate = jax.nn.sigmoid(rmsnorm(h, norm_ple[i]) @ w_ple_gate[i] + b_ple_gate[i])
        h = h + gate * (p[i] @ w_ple_proj[i])
    return rmsnorm(h, norm_f)
```

```cpp
#define MK_PER_PHASE 1
#include <hip/hip_runtime.h>
#include <hip/hip_bf16.h>
#include <cstdio>
#include <cstdint>
#include <cmath>
namespace pg8 {
#define PG8_LAS __attribute__((address_space(3)))
typedef unsigned short bf16_t;
typedef short bf16x8 __attribute__((ext_vector_type(8)));
typedef float f32x4 __attribute__((ext_vector_type(4)));
typedef unsigned u32x4 __attribute__((ext_vector_type(4)));
constexpr int BM = 256, BK = 64, HALF = 128, HTB = HALF * BK * 2  , STAGE_BYTES = 8 * HTB, NXCD = 8, WGM = 8;

__host__ __device__ __forceinline__ int lds_byte(int r, int c) { const int st = (r >> 4) * 2 + (c >> 5), rr = r & 15, cc = c & 31, ob = rr * 64 + cc * 2; return st * 1024 + (ob ^ (((ob >> 9) & 1) << 5)); }
__host__ __device__ __forceinline__ void stage_rc(int b, int& R, int& C) { const int st = b / 1024, sb = b % 1024, swz = sb ^ (((sb >> 9) & 1) << 5); R = (st >> 1) * 16 + swz / 64; C = (st & 1) * 32 + (swz % 64) / 2; }
__host__ __device__ __forceinline__ int perm32(int rho) { const int n = rho >> 4, i = rho & 15; return 8 * (i >> 2) + 4 * n + (i & 3); }

struct Unit { int pm, pn; };
struct Gemm { const bf16_t* A; const bf16_t* Bt; int M, N, K; };

__device__ __forceinline__ unsigned cvt_pk_bf16(float lo, float hi) { unsigned r; asm volatile("v_cvt_pk_bf16_f32 %0, %1, %2" : "=v"(r) : "v"(lo), "v"(hi)); return r; }

struct PanelOrder {
    int nunits, G, c;
    __host__ __device__ void init(int N, int G_, int c_) { nunits = 64 * (N / BM); G = G_; c = c_; }
    __host__ __device__ bool next(int i, Unit& u) const {
        const long L = (long)i * G + c; if (L >= nunits) return false;
        u.pm = (int)((L & 7) * 8 + ((L >> 3) & 7)); u.pn = (int)(L >> 6); return true;
    }
    __device__ __forceinline__ void a_ready(const Unit&) const {}
    __device__ __forceinline__ void done(const Unit&) const {}
};

__device__ __forceinline__ float sigmoid_f(float x) { return __builtin_amdgcn_rcpf(1.0f + __builtin_amdgcn_exp2f(-1.4426950408889634f * x)); }
__device__ __forceinline__ f32x4 silu4(f32x4 g) { f32x4 r; r[0] = g[0] * sigmoid_f(g[0]); r[1] = g[1] * sigmoid_f(g[1]); r[2] = g[2] * sigmoid_f(g[2]); r[3] = g[3] * sigmoid_f(g[3]); return r; }
__device__ __forceinline__ f32x4 sig4(f32x4 g) { f32x4 r; r[0] = sigmoid_f(g[0]); r[1] = sigmoid_f(g[1]); r[2] = sigmoid_f(g[2]); r[3] = sigmoid_f(g[3]); return r; }

struct XEpi {
    static constexpr bool PERM = true, AFTER_DRAIN = false;
    bf16_t* O1; int ld1; bf16_t* O2; int ld2; int nglu; int act; int use_rstd; const PG8_LAS float* rs;
    __device__ __forceinline__ void operator()(const f32x4 (&acc)[2][2][4][2], const Unit& u, int wr, int wc, int fr, int fq) const {
        asm volatile("" : "+v"(fr), "+v"(fq));
        const int rl0 = wr * 64 + fr;
        if (u.pn < nglu) {
            bf16_t* base = O1 + (size_t)(u.pm * BM) * ld1 + u.pn * 128 + wc * 32 + 8 * fq;
#pragma unroll
            for (int ai = 0; ai < 2; ++ai)
#pragma unroll
                for (int m = 0; m < 4; ++m) { const int rl = rl0 + ai * HALF + m * 16; const float s = use_rstd ? rs[rl] : 1.f;
                    f32x4 g0 = acc[ai][0][m][0] * s, g1 = acc[ai][0][m][1] * s; const f32x4 u0 = acc[ai][1][m][0] * s, u1 = acc[ai][1][m][1] * s;
                    if (act) { g0 = silu4(g0); g1 = silu4(g1); }
                    const f32x4 v0 = g0 * u0, v1 = g1 * u1;
                    u32x4 w; w.x = cvt_pk_bf16(v0[0], v0[1]); w.y = cvt_pk_bf16(v0[2], v0[3]); w.z = cvt_pk_bf16(v1[0], v1[1]); w.w = cvt_pk_bf16(v1[2], v1[3]);
                    *(u32x4*)(base + (size_t)rl * ld1) = w; }
        } else {
            bf16_t* base = O2 + (size_t)(u.pm * BM) * ld2 + (u.pn - nglu) * BM + wc * 32 + 8 * fq;
#pragma unroll
            for (int ai = 0; ai < 2; ++ai)
#pragma unroll
                for (int m = 0; m < 4; ++m) { const int rl = rl0 + ai * HALF + m * 16; const float s = use_rstd ? rs[rl] : 1.f;
#pragma unroll
                    for (int bj = 0; bj < 2; ++bj) { const f32x4 v0 = acc[ai][bj][m][0] * s, v1 = acc[ai][bj][m][1] * s;
                        u32x4 w; w.x = cvt_pk_bf16(v0[0], v0[1]); w.y = cvt_pk_bf16(v0[2], v0[3]); w.z = cvt_pk_bf16(v1[0], v1[1]); w.w = cvt_pk_bf16(v1[2], v1[3]);
                        *(u32x4*)(base + (size_t)rl * ld2 + bj * HALF) = w; } }
        }
    }
};

struct REpi {
    static constexpr bool PERM = true, AFTER_DRAIN = false;
    const float* Hin; float* H; bf16_t* HB; float* SSQ; float scale; int mode; const bf16_t* PP; const float* bias; const PG8_LAS float* rs;
    __device__ __forceinline__ void operator()(const f32x4 (&acc)[2][2][4][2], const Unit& u, int wr, int wc, int fr, int fq) const {
        asm volatile("" : "+v"(fr), "+v"(fq));
        constexpr int LD = 2048;
        const int rl0 = wr * 64 + fr, col0 = u.pn * BM + wc * 32 + 8 * fq;
        f32x4 bv[2][2];
#pragma unroll
        for (int bj = 0; bj < 2; ++bj)
#pragma unroll
            for (int n = 0; n < 2; ++n) bv[bj][n] = mode ? *(const f32x4*)(bias + col0 + bj * HALF + 4 * n) : (f32x4){0.f, 0.f, 0.f, 0.f};
#pragma unroll
        for (int ai = 0; ai < 2; ++ai)
#pragma unroll
            for (int m = 0; m < 4; ++m) { const int rl = rl0 + ai * HALF + m * 16; const int row = u.pm * BM + rl; const float s = mode ? rs[rl] : scale; float ss = 0.f;
#pragma unroll
                for (int bj = 0; bj < 2; ++bj) { const size_t off = (size_t)row * LD + col0 + bj * HALF;
                    const f32x4 h0 = *(const f32x4*)(Hin + off), h1 = *(const f32x4*)(Hin + off + 4);
                    f32x4 a0 = acc[ai][bj][m][0] * s, a1 = acc[ai][bj][m][1] * s;
                    if (mode) { const u32x4 pw = *(const u32x4*)(PP + off);
                        const f32x4 p0 = {__uint_as_float(pw.x << 16), __uint_as_float(pw.x & 0xffff0000u), __uint_as_float(pw.y << 16), __uint_as_float(pw.y & 0xffff0000u)};
                        const f32x4 p1 = {__uint_as_float(pw.z << 16), __uint_as_float(pw.z & 0xffff0000u), __uint_as_float(pw.w << 16), __uint_as_float(pw.w & 0xffff0000u)};
                        a0 = sig4(a0 + bv[bj][0]) * p0; a1 = sig4(a1 + bv[bj][1]) * p1; }
                    const f32x4 n0 = h0 + a0, n1 = h1 + a1;
                    *(f32x4*)(H + off) = n0; *(f32x4*)(H + off + 4) = n1;
                    u32x4 w; w.x = cvt_pk_bf16(n0[0], n0[1]); w.y = cvt_pk_bf16(n0[2], n0[3]); w.z = cvt_pk_bf16(n1[0], n1[1]); w.w = cvt_pk_bf16(n1[2], n1[3]);
                    *(u32x4*)(HB + off) = w;
                    ss += (n0[0] * n0[0] + n0[1] * n0[1]) + (n0[2] * n0[2] + n0[3] * n0[3]) + (n1[0] * n1[0] + n1[1] * n1[1]) + (n1[2] * n1[2] + n1[3] * n1[3]); }
                ss += __shfl_xor(ss, 16); ss += __shfl_xor(ss, 32);
                if (fq == 0) SSQ[(size_t)row * 32 + u.pn * 4 + wc] = ss;
                if (m & 1) asm volatile("" ::: "memory"); }
    }
};

template <class Epi, class Sched, bool ALIGN_EPI = false, bool SP2 = false>
__device__ __forceinline__ void gemm_phase(PG8_LAS unsigned char* lds, const Gemm g, const Sched& S, const Epi& E) {
    int tid_o = threadIdx.x; asm volatile("" : "+v"(tid_o));
    const int tid = tid_o, wid = __builtin_amdgcn_readfirstlane(tid >> 6), lane = tid & 63, wr = wid >> 2, wc = wid & 3, fr = lane & 15, fq = lane >> 4;
    const int K = g.K, nt = K / BK;
    unsigned voffA[2], voffB[2];
#pragma unroll
    for (int i = 0; i < 2; ++i) { int R, C; stage_rc(tid * 16 + i * 8192, R, C); const int Rb = Epi::PERM ? ((R & ~31) + perm32(R & 31)) : R;
        voffA[i] = (unsigned)(R * K + C) * 2u; voffB[i] = (unsigned)(Rb * K + C) * 2u; }
    const size_t kstep = (size_t)(BK * 2);
    const size_t hstep = (size_t)HALF * K * 2;
    const size_t tstep = 2 * hstep;
    const unsigned ldsw = (unsigned)wid * 1024u;
    const int aoff = lds_byte(wr * 64 + fr, fq * 8), boff = lds_byte(wc * 32 + fr, fq * 8);
#define PG8_SA(b, h) (((b) * 2 + (h)) * HTB)
#define PG8_SB(b, h) ((4 + (b) * 2 + (h)) * HTB)
#define PG8_STAGE(bufoff, gbase, voff) do { _Pragma("unroll") for (int _i = 0; _i < 2; ++_i) \
        __builtin_amdgcn_global_load_lds((const unsigned*)((const char*)(gbase) + (voff)[_i]), (PG8_LAS unsigned*)(lds + (bufoff) + ldsw + _i * 8192), 16, 0, 0); } while (0)
#define PG8_LDA(dst, b, h) do { _Pragma("unroll") for (int m = 0; m < 4; ++m) _Pragma("unroll") for (int k = 0; k < 2; ++k) dst[m][k] = *(const PG8_LAS bf16x8*)(lds + PG8_SA(b, h) + aoff + m * 2048 + k * 1024); } while (0)
#define PG8_LDB(dst, b, h) do { _Pragma("unroll") for (int n = 0; n < 2; ++n) _Pragma("unroll") for (int k = 0; k < 2; ++k) dst[n][k] = *(const PG8_LAS bf16x8*)(lds + PG8_SB(b, h) + boff + n * 2048 + k * 1024); } while (0)
#define PG8_MMA(ai, bj, At, Bt) do { __builtin_amdgcn_s_setprio(1); _Pragma("unroll") for (int m = 0; m < 4; ++m) _Pragma("unroll") for (int n = 0; n < 2; ++n) _Pragma("unroll") for (int k = 0; k < 2; ++k) \
        acc[ai][bj][m][n] = __builtin_amdgcn_mfma_f32_16x16x32_bf16(Bt[n][k], At[m][k], acc[ai][bj][m][n], 0, 0, 0); __builtin_amdgcn_s_setprio(0); } while (0)
#define PG8_WAIT_V(n) asm volatile("s_waitcnt vmcnt(" #n ")" ::: "memory")
#define PG8_WAIT_L(n) asm volatile("s_waitcnt lgkmcnt(" #n ")" ::: "memory")
#define PG8_BAR __builtin_amdgcn_s_barrier()
#define PG8_SCHED __builtin_amdgcn_sched_barrier(0)
    Unit cur, nxt; int ui = 0;
    if (!S.next(0, cur)) return;
    f32x4 acc[2][2][4][2];
#pragma unroll
    for (int a = 0; a < 2; ++a)
#pragma unroll
        for (int b = 0; b < 2; ++b)
#pragma unroll
            for (int m = 0; m < 4; ++m)
#pragma unroll
                for (int n = 0; n < 2; ++n) acc[a][b][m][n] = (f32x4){0.f, 0.f, 0.f, 0.f};
    bf16x8 At[4][2], B0[2][2], B1[2][2];
    const char* cA = (const char*)g.A + (size_t)cur.pm * tstep; const char* cB = (const char*)g.Bt + (size_t)cur.pn * tstep;
    S.a_ready(cur);
    if constexpr (SP2) {
        PG8_STAGE(PG8_SB(0, 0), cB, voffB); PG8_STAGE(PG8_SB(0, 1), cB + hstep, voffB); PG8_STAGE(PG8_SA(0, 0), cA, voffA); PG8_STAGE(PG8_SA(0, 1), cA + hstep, voffA);
        if (wr == 1) PG8_BAR;
        PG8_WAIT_V(2); PG8_BAR;
        PG8_STAGE(PG8_SB(1, 0), cB + kstep, voffB); PG8_STAGE(PG8_SA(1, 0), cA + kstep, voffA); PG8_STAGE(PG8_SB(1, 1), cB + hstep + kstep, voffB);
        PG8_WAIT_V(6); PG8_BAR;
    } else {
        PG8_STAGE(PG8_SB(0, 0), cB, voffB); PG8_STAGE(PG8_SA(0, 0), cA, voffA); PG8_STAGE(PG8_SB(0, 1), cB + hstep, voffB); PG8_STAGE(PG8_SA(0, 1), cA + hstep, voffA);
        if (wr == 1) PG8_BAR;
        PG8_WAIT_V(4); PG8_BAR;
        PG8_STAGE(PG8_SB(1, 0), cB + kstep, voffB); PG8_STAGE(PG8_SA(1, 0), cA + kstep, voffA); PG8_STAGE(PG8_SB(1, 1), cB + hstep + kstep, voffB);
        PG8_WAIT_V(6); PG8_BAR;
    }
    for (;;) {
        const bool has_next = S.next(ui + 1, nxt);
        const char* nA = has_next ? (const char*)g.A + (size_t)nxt.pm * tstep : cA; const char* nB = has_next ? (const char*)g.Bt + (size_t)nxt.pn * tstep : cB;
        for (int t = 0; t < nt; t += 2) {
            const bool last = (t == nt - 2);
            const char* a1 = cA + (size_t)(t + 1) * kstep;
            const char* a2 = last ? nA : cA + (size_t)(t + 2) * kstep; const char* b2 = last ? nB : cB + (size_t)(t + 2) * kstep;
            const char* a3 = a2 + kstep; const char* b3 = b2 + kstep;
            if (last && has_next) S.a_ready(nxt);
            if constexpr (SP2) {
            PG8_LDB(B0, 0, 0); PG8_LDB(B1, 0, 1); PG8_SCHED; PG8_LDA(At, 0, 0); PG8_STAGE(PG8_SA(1, 1), a1 + hstep, voffA);
            PG8_WAIT_V(8); PG8_WAIT_L(0); PG8_BAR; PG8_MMA(0, 0, At, B0); PG8_MMA(0, 1, At, B1); PG8_BAR; PG8_SCHED;
            PG8_LDA(At, 0, 1); PG8_STAGE(PG8_SB(0, 0), b2, voffB); PG8_STAGE(PG8_SB(0, 1), b2 + hstep, voffB); PG8_STAGE(PG8_SA(0, 0), a2, voffA);
            PG8_WAIT_V(8); PG8_WAIT_L(0); PG8_BAR; PG8_MMA(1, 0, At, B0); PG8_MMA(1, 1, At, B1); PG8_BAR; PG8_SCHED;
            PG8_LDB(B0, 1, 0); PG8_LDB(B1, 1, 1); PG8_SCHED; PG8_LDA(At, 1, 0); PG8_STAGE(PG8_SA(0, 1), a2 + hstep, voffA);
            PG8_WAIT_V(8); PG8_WAIT_L(0); PG8_BAR; PG8_MMA(0, 0, At, B0); PG8_MMA(0, 1, At, B1); PG8_BAR; PG8_SCHED;
            PG8_LDA(At, 1, 1); PG8_STAGE(PG8_SB(1, 0), b3, voffB); PG8_STAGE(PG8_SB(1, 1), b3 + hstep, voffB); PG8_STAGE(PG8_SA(1, 0), a3, voffA);
            PG8_WAIT_V(8); PG8_WAIT_L(0); PG8_BAR; PG8_MMA(1, 0, At, B0); PG8_MMA(1, 1, At, B1); PG8_BAR; PG8_SCHED;
            } else {
            PG8_LDB(B0, 0, 0); PG8_SCHED; PG8_LDA(At, 0, 0); PG8_STAGE(PG8_SA(1, 1), a1 + hstep, voffA);
            PG8_WAIT_L(8); PG8_BAR; PG8_WAIT_L(0); PG8_MMA(0, 0, At, B0); PG8_BAR; PG8_SCHED;
            PG8_LDB(B1, 0, 1); PG8_STAGE(PG8_SB(0, 0), b2, voffB);
            PG8_BAR; PG8_WAIT_L(0); PG8_MMA(0, 1, At, B1); PG8_BAR;
            PG8_LDA(At, 0, 1); PG8_STAGE(PG8_SA(0, 0), a2, voffA);
            PG8_BAR; PG8_WAIT_L(0); PG8_MMA(1, 0, At, B0); PG8_BAR; PG8_SCHED;
            PG8_STAGE(PG8_SB(0, 1), b2 + hstep, voffB);
            PG8_WAIT_V(6); PG8_BAR; PG8_MMA(1, 1, At, B1); PG8_BAR;
            PG8_LDB(B0, 1, 0); PG8_SCHED; PG8_LDA(At, 1, 0); PG8_STAGE(PG8_SA(0, 1), a2 + hstep, voffA);
            PG8_WAIT_L(8); PG8_BAR; PG8_WAIT_L(0); PG8_MMA(0, 0, At, B0); PG8_BAR; PG8_SCHED;
            PG8_LDB(B1, 1, 1); PG8_STAGE(PG8_SB(1, 0), b3, voffB);
            PG8_BAR; PG8_WAIT_L(0); PG8_MMA(0, 1, At, B1); PG8_BAR;
            PG8_LDA(At, 1, 1); PG8_STAGE(PG8_SA(1, 0), a3, voffA);
            PG8_BAR; PG8_WAIT_L(0); PG8_MMA(1, 0, At, B0); PG8_BAR; PG8_SCHED;
            PG8_STAGE(PG8_SB(1, 1), b3 + hstep, voffB);
            PG8_WAIT_V(6); PG8_BAR; PG8_MMA(1, 1, At, B1); PG8_BAR;
            }
        }
        if constexpr (ALIGN_EPI) { if (wr == 0) PG8_BAR; }
        if constexpr (!Epi::AFTER_DRAIN) { E(acc, cur, wr, wc, fr, fq); S.done(cur); }
        if (!has_next) break;
#pragma unroll
        for (int a = 0; a < 2; ++a)
#pragma unroll
            for (int b = 0; b < 2; ++b)
#pragma unroll
                for (int m = 0; m < 4; ++m)
#pragma unroll
                    for (int n = 0; n < 2; ++n) acc[a][b][m][n] = (f32x4){0.f, 0.f, 0.f, 0.f};
        cur = nxt; cA = nA; cB = nB; ++ui;
        if constexpr (ALIGN_EPI) { if (wr == 1) PG8_BAR; }
    }
    PG8_WAIT_V(0);
    if constexpr (!ALIGN_EPI) { if (wr == 0) PG8_BAR; }
    PG8_BAR;
    if constexpr (Epi::AFTER_DRAIN) { E.fused(acc, cur, wr, wc, fr, fq, lds, wid, lane); S.done(cur); }
#undef PG8_SA
#undef PG8_SB
#undef PG8_STAGE
#undef PG8_LDA
#undef PG8_LDB
#undef PG8_MMA
#undef PG8_WAIT_V
#undef PG8_WAIT_L
#undef PG8_BAR
#undef PG8_SCHED
}
}
namespace swa {
using bf16 = __hip_bfloat16;
typedef short bf16x8 __attribute__((ext_vector_type(8)));
typedef short s16x4 __attribute__((ext_vector_type(4)));
typedef float f32x16 __attribute__((ext_vector_type(16)));
typedef float f32x4 __attribute__((ext_vector_type(4)));
typedef unsigned u32x4 __attribute__((ext_vector_type(4)));
constexpr int D = 128;
constexpr float SCALE = 0.08838834764831845f;
constexpr float THR = 8.f;
constexpr int NW = 8, QBLK = 32, KVBLK = 64, QB = NW * QBLK;
constexpr int SHM_V = KVBLK * D * 2, SHM_K = KVBLK * D * 2;
constexpr int LDS_BYTES = 2 * SHM_V + 2 * SHM_K + NW * 64 * 4;

#define KSWZ(row, colB) ((row) * 256 + ((colB) ^ (((row) & 7) << 4)))
#define SBAR() __builtin_amdgcn_sched_barrier(0)
__device__ __forceinline__ int v_st(int k, int c) { const int kk = (k & ~0xC) | ((k & 4) << 1) | ((k & 8) >> 1); return ((kk >> 3) * 4 + (c >> 5)) * 512 + ((kk & 7) * 32 + (c & 31)) * 2; }
__device__ __forceinline__ int v_rd_base(int lane) { return ((lane & 3) << 3) | (((lane >> 2) & 3) << 6) | (((lane >> 4) & 1) << 5) | (((lane >> 5) & 1) << 8); }
constexpr int v_rd_off(int d0, int ks, int half) { return d0 * 512 + ks * 4096 + half * 2048; }
__device__ __forceinline__ int crow(int r, int hi) { return (r & 3) + 8 * (r >> 2) + 4 * hi; }
__device__ __forceinline__ unsigned cvtpk(float lo, float hi) { unsigned r; asm volatile("v_cvt_pk_bf16_f32 %0, %1, %2" : "=v"(r) : "v"(lo), "v"(hi)); return r; }
__device__ __forceinline__ bf16x8 load8(const bf16* p) { return *reinterpret_cast<const bf16x8*>(p); }
__device__ __forceinline__ void mask_tile(f32x16& p0, f32x16& p1, int dq, unsigned W) {
    const float NEG = -__builtin_inff();
#pragma unroll
    for (int r = 0; r < 16; ++r) {
        const int c = (r & 3) + 8 * (r >> 2);
        if ((unsigned)(dq - c) >= W) p0[r] = NEG;
        if ((unsigned)(dq - c - 32) >= W) p1[r] = NEG;
    }
}
__device__ __forceinline__ void partialSM(f32x16& p0, f32x16& p1, float& m_reg, float& mn, float& alpha) {
    float pmax = p0[0]; for (int r = 1; r < 16; ++r) pmax = fmaxf(pmax, p0[r]); for (int r = 0; r < 16; ++r) pmax = fmaxf(pmax, p1[r]);
    { auto rr = __builtin_amdgcn_permlane32_swap(__float_as_uint(pmax), __float_as_uint(pmax), false, false);
      pmax = fmaxf(__uint_as_float(rr[0]), __uint_as_float(rr[1])); }
    constexpr float C2 = 1.4426950408889634f * SCALE;
    if (__builtin_expect(__all((pmax - m_reg) * SCALE <= THR), 1)) { mn = m_reg; alpha = 1.f; }
    else { mn = fmaxf(m_reg, pmax); alpha = __builtin_amdgcn_exp2f((m_reg - mn) * C2); m_reg = mn; }
    const float mnL = -mn * C2;
    for (int r = 0; r < 16; ++r) p0[r] = fmaf(p0[r], C2, mnL); for (int r = 0; r < 16; ++r) p1[r] = fmaf(p1[r], C2, mnL);
    for (int r = 0; r < 16; ++r) p0[r] = __builtin_amdgcn_exp2f(p0[r]);
}
__device__ __forceinline__ void finishSM(f32x16& p0, f32x16& p1, float alpha, float& l_reg, bf16x8& pa0, bf16x8& pa1, bf16x8& pa2, bf16x8& pa3) {
    for (int r = 0; r < 16; ++r) p1[r] = __builtin_amdgcn_exp2f(p1[r]);
    float ps = 0; for (int r = 0; r < 16; ++r) ps += p0[r]; for (int r = 0; r < 16; ++r) ps += p1[r];
    { auto rr = __builtin_amdgcn_permlane32_swap(__float_as_uint(ps), __float_as_uint(ps), false, false);
      ps = __uint_as_float(rr[0]) + __uint_as_float(rr[1]); }
    l_reg = l_reg * alpha + ps;
#define PK4(P, B_, OUT) do { unsigned a0 = cvtpk(P[B_+0], P[B_+1]), a1 = cvtpk(P[B_+2], P[B_+3]);                          \
        unsigned b0 = cvtpk(P[B_+4], P[B_+5]), b1 = cvtpk(P[B_+6], P[B_+7]);                                             \
        auto r0 = __builtin_amdgcn_permlane32_swap(a0, b0, false, false); auto r1 = __builtin_amdgcn_permlane32_swap(a1, b1, false, false); \
        u32x4 w = {r0[0], r1[0], r0[1], r1[1]}; OUT = *reinterpret_cast<bf16x8*>(&w); } while (0)
    PK4(p0, 0, pa0); PK4(p0, 8, pa1); PK4(p1, 0, pa2); PK4(p1, 8, pa3);
#undef PK4
}
template <int KB, bool SK>
__device__ __forceinline__ void qkt(f32x16& p0, f32x16& p1, const char* K_lds, int r32, int hi, const bf16x8* qr, bool act) {
    if (SK && !act) { const float NEG = -__builtin_inff();
#pragma unroll
        for (int r = 0; r < 16; ++r) { p0[r] = NEG; p1[r] = NEG; } return; }
    p0 = f32x16{}; p1 = f32x16{};
    const char* kb[4];
#pragma unroll
    for (int dd = 0; dd < 4; ++dd) kb[dd] = K_lds + KB * SHM_K + KSWZ(r32, (dd * 16 + hi * 8) * 2);
#pragma unroll
    for (int d0 = 0; d0 < 8; ++d0) { const char* a = kb[d0 & 3] + (d0 >> 2) * 128;
        bf16x8 b0 = *reinterpret_cast<const bf16x8*>(a);
        bf16x8 b1 = *reinterpret_cast<const bf16x8*>(a + 32 * 256);
        p0 = __builtin_amdgcn_mfma_f32_32x32x16_bf16(b0, qr[d0], p0, 0, 0, 0);
        p1 = __builtin_amdgcn_mfma_f32_32x32x16_bf16(b1, qr[d0], p1, 0, 0, 0); }
}
template <int VB, bool SK>
__device__ __forceinline__ void pv_tile(f32x16* o, int vb0, bf16x8 pa0, bf16x8 pa1, bf16x8 pa2, bf16x8 pa3, bool act) {
    if (SK && !act) return;
#define TRRD(dst, off) asm volatile("ds_read_b64_tr_b16 %0, %1 offset:%2" : "=&v"(dst) : "v"(vb0), "i"(off) : "memory")
#define PV_D0(d0) do { s16x4 l0, l1, l2, l3, h0, h1, h2, h3; constexpr int b_ = VB * SHM_V + v_rd_off(d0, 0, 0); \
        TRRD(l0, b_); TRRD(h0, b_ + 2048); TRRD(l1, b_ + 4096); TRRD(h1, b_ + 6144); TRRD(l2, b_ + 8192); TRRD(h2, b_ + 10240); TRRD(l3, b_ + 12288); TRRD(h3, b_ + 14336); \
        asm volatile("s_waitcnt lgkmcnt(0)" ::: "memory"); SBAR();   \
        o[d0] = __builtin_amdgcn_mfma_f32_32x32x16_bf16(pa0, (bf16x8){l0[0], l0[1], l0[2], l0[3], h0[0], h0[1], h0[2], h0[3]}, o[d0], 0, 0, 0);   \
        o[d0] = __builtin_amdgcn_mfma_f32_32x32x16_bf16(pa1, (bf16x8){l1[0], l1[1], l1[2], l1[3], h1[0], h1[1], h1[2], h1[3]}, o[d0], 0, 0, 0);   \
        o[d0] = __builtin_amdgcn_mfma_f32_32x32x16_bf16(pa2, (bf16x8){l2[0], l2[1], l2[2], l2[3], h2[0], h2[1], h2[2], h2[3]}, o[d0], 0, 0, 0);   \
        o[d0] = __builtin_amdgcn_mfma_f32_32x32x16_bf16(pa3, (bf16x8){l3[0], l3[1], l3[2], l3[3], h3[0], h3[1], h3[2], h3[3]}, o[d0], 0, 0, 0); } while (0)
    PV_D0(0); PV_D0(1); PV_D0(2); PV_D0(3);
#undef PV_D0
#undef TRRD
}

struct BlockRef { const bf16* Q; const bf16* K; const bf16* V; bf16* O; float* L; int P0, skv, qs, kvs, os, ls; };
struct Seam { bf16x8 qr[8]; bf16x8 st_v0, st_v1, st_k0, st_k1; };
__device__ __forceinline__ int swa_jlo(int P0, int W) { const int lowk = P0 - W + 1; return lowk > 0 ? lowk / KVBLK : 0; }
#define VMW() asm volatile("s_waitcnt vmcnt(0)" ::: "memory")
#define VMWN(n) asm volatile("s_waitcnt vmcnt(%0)" :: "i"(n) : "memory")
#define SLOAD_H(Kp, Vp, k0, st) do { const unsigned lo_ = (unsigned)(sr * (st) + sc) * 2u; const size_t t0_ = (size_t)(k0) * (st) * 2, t1_ = t0_ + (size_t)32 * (st) * 2;          \
                         S.st_v0 = *(const bf16x8*)((const char*)(Vp) + t0_ + lo_); S.st_v1 = *(const bf16x8*)((const char*)(Vp) + t1_ + lo_);              \
                         S.st_k0 = *(const bf16x8*)((const char*)(Kp) + t0_ + lo_); S.st_k1 = *(const bf16x8*)((const char*)(Kp) + t1_ + lo_); } while (0)
#define SWRITE_HK(bf) do { *(bf16x8*)(K_lds + (bf) * SHM_K + kws) = S.st_k0; *(bf16x8*)(K_lds + (bf) * SHM_K + kws + 32 * 256) = S.st_k1; } while (0)
#define SWRITE_HV(bf) do { *(bf16x8*)(V_lds + (bf) * SHM_V + vst0) = S.st_v0; *(bf16x8*)(V_lds + (bf) * SHM_V + vst1) = S.st_v1; } while (0)
#define SWRITE_H(bf) do { SWRITE_HV(bf); SWRITE_HK(bf); } while (0)
__device__ __forceinline__ void causal_swa_prime(const BlockRef& cur, int W, char* lds, Seam& S) {
    int tid_o = threadIdx.x; asm volatile("" : "+v"(tid_o));
    const int tid = tid_o, wid = __builtin_amdgcn_readfirstlane(tid >> 6), lane = tid & 63, r32 = lane & 31, hi = lane >> 5;
    const int sr = tid >> 4, sc = (tid & 15) * 8, kws = KSWZ(sr, sc * 2); char* K_lds = lds + 2 * SHM_V;
    const int kb0 = swa_jlo(cur.P0, W) * KVBLK;
    { const unsigned qo_ = (unsigned)((wid * QBLK + r32) * cur.qs + hi * 8) * 2u;
      for (int d0 = 0; d0 < 8; ++d0) S.qr[d0] = *(const bf16x8*)((const char*)cur.Q + qo_ + d0 * 32); }
    SLOAD_H(cur.K, cur.V, kb0, cur.kvs); VMW(); SWRITE_HK(0);
    __syncthreads();
}
template <bool SK>
__device__ __forceinline__ void causal_swa_block(const BlockRef& cur, const BlockRef& nxt, int W, char* lds, Seam& S) {
    int tid_o = threadIdx.x; asm volatile("" : "+v"(tid_o));
    const int tid = tid_o, wid = __builtin_amdgcn_readfirstlane(tid >> 6), lane = tid & 63, r32 = lane & 31, hi = lane >> 5;
    const int skv = cur.skv;
    const int j_lo = swa_jlo(cur.P0, W);
    int j_hi = (cur.P0 + QB - 1) / KVBLK + 1; if (j_hi > skv / KVBLK) j_hi = skv / KVBLK;
    const int NT = j_hi - j_lo;
    const int kbn = swa_jlo(nxt.P0, W) * KVBLK;
    const int qlo = cur.P0 + wid * QBLK, qm = qlo + r32 - 4 * hi;
    char* V_lds = lds; char* K_lds = lds + 2 * SHM_V;
    float* ws = (float*)(lds + 2 * SHM_V + 2 * SHM_K) + wid * 64; float* li_l = ws, * al_l = ws + 32;
    float m_reg = -1e30f, l_reg = 0; f32x16 o[4] = {};
    const int sr = tid >> 4, sc = (tid & 15) * 8, vst0 = v_st(sr, sc), vst1 = v_st(32 + sr, sc), kws = KSWZ(sr, sc * 2);
    const int vb0 = (int)(uintptr_t)V_lds + v_rd_base(lane);
    const bf16* Kh = cur.K; const bf16* Vh = cur.V; const int kvs = cur.kvs;
#define RESC(a) do { if (__any((a) < 1.f)) { if (hi == 0) al_l[r32] = (a); asm volatile("s_waitcnt lgkmcnt(0)" ::: "memory");              \
                     for (int d_ = 0; d_ < 4; ++d_) for (int r = 0; r < 16; ++r) o[d_][r] *= al_l[crow(r, hi)]; } } while (0)
#define KBASE(t) ((j_lo + (t)) * KVBLK)
#define ACT(t) (KBASE(t) <= qlo + QBLK - 1 && KBASE(t) + KVBLK - 1 >= qlo - W + 1)
#define MASKT(P0_, P1_, t) do { const int kb_ = KBASE(t); if ((!SK || ACT(t)) && (kb_ + KVBLK - 1 > qlo || kb_ <= qlo + QBLK - 1 - W)) mask_tile(P0_, P1_, qm - kb_, (unsigned)W); } while (0)
    constexpr int NQL = 8;
#define SEAM_K0() do { VMWN(NQL); SWRITE_HK(0); SBAR(); } while (0)
    f32x16 pA0, pA1, pB0, pB1; float mnA, mnB, alA, alB; bf16x8 pa0, pa1, pa2, pa3;
    SWRITE_HV(0); SBAR();
    if (NT > 1) { SLOAD_H(Kh, Vh, KBASE(1), kvs); }
    SBAR(); qkt<0, SK>(pA0, pA1, K_lds, r32, hi, S.qr, ACT(0));
    MASKT(pA0, pA1, 0); partialSM(pA0, pA1, m_reg, mnA, alA);
    if (NT > 1) { VMW(); SWRITE_H(1); }
    __syncthreads();
#define HALF_STEP(PX0, PX1, mnX, alX, PY0, PY1, alY, t, KB, VB, SB) do {                                                      \
        SBAR(); qkt<KB, SK>(PX0, PX1, K_lds, r32, hi, S.qr, ACT(t));                                             \
        finishSM(PY0, PY1, alY, l_reg, pa0, pa1, pa2, pa3); SBAR();                                                           \
        if ((t) + 1 < NT) { SLOAD_H(Kh, Vh, KBASE((t) + 1), kvs); SBAR(); }                                               \
        pv_tile<VB, SK>(o, vb0, pa0, pa1, pa2, pa3, ACT((t) - 1)); MASKT(PX0, PX1, (t)); partialSM(PX0, PX1, m_reg, mnX, alX);                                        \
        __syncthreads();                                                                                                      \
        if ((t) + 1 < NT) { VMW(); SWRITE_H(SB); }                                                                          \
        RESC(alX); __syncthreads(); } while (0)
    for (int t = 1; t + 1 < NT; t += 2) {
        HALF_STEP(pB0, pB1, mnB, alB, pA0, pA1, alA, t, 1, 0, 0);
        HALF_STEP(pA0, pA1, mnA, alA, pB0, pB1, alB, t + 1, 0, 1, 1);
    }
    const bool even = (NT & 1) == 0;
    if (even) { SBAR(); qkt<1, SK>(pB0, pB1, K_lds, r32, hi, S.qr, ACT(NT - 1)); SBAR(); }
    { SLOAD_H(nxt.K, nxt.V, kbn, nxt.kvs); SBAR();
      const unsigned qo_ = (unsigned)((wid * QBLK + r32) * nxt.qs + hi * 8) * 2u;
#pragma unroll
      for (int d0 = 0; d0 < 8; ++d0) S.qr[d0] = *(const bf16x8*)((const char*)nxt.Q + qo_ + d0 * 32); }
    SBAR();
    finishSM(pA0, pA1, alA, l_reg, pa0, pa1, pa2, pa3); SBAR();
    pv_tile<0, SK>(o, vb0, pa0, pa1, pa2, pa3, ACT(even ? NT - 2 : NT - 1));
    if (even) { MASKT(pB0, pB1, NT - 1); partialSM(pB0, pB1, m_reg, mnB, alB); __syncthreads(); RESC(alB);
        finishSM(pB0, pB1, alB, l_reg, pa0, pa1, pa2, pa3); SBAR(); pv_tile<1, SK>(o, vb0, pa0, pa1, pa2, pa3, ACT(NT - 1)); }
    SBAR(); SEAM_K0();
    if (hi == 0) li_l[r32] = l_reg; asm volatile("s_waitcnt lgkmcnt(0)" ::: "memory");
    float rli[16];
#pragma unroll
    for (int r = 0; r < 16; ++r) rli[r] = __builtin_amdgcn_rcpf(li_l[crow(r, hi)]);
    char* Ow = (char*)cur.O + (size_t)(wid * QBLK) * cur.os * 2; const unsigned oo_ = (unsigned)(4 * hi * cur.os + r32) * 2u;
#pragma unroll
    for (int r = 0; r < 16; ++r) { char* Or = Ow + (size_t)(((r & 3) + 8 * (r >> 2)) * cur.os) * 2;
#pragma unroll
        for (int d0 = 0; d0 < 4; ++d0) { const float v = o[d0][r] * rli[r];
            const float vn = __shfl_xor(v, 1);
            if ((r32 & 1) == 0) *(unsigned*)(Or + oo_ + d0 * 64) = cvtpk(v, vn); } }
    if (cur.L != nullptr && hi == 0) cur.L[(size_t)(wid * QBLK + r32) * cur.ls] = m_reg * (1.4426950408889634f * SCALE) + __builtin_amdgcn_logf(l_reg);
    __syncthreads();
#undef RESC
#undef KBASE
#undef ACT
#undef MASKT
#undef SEAM_K0
#undef HALF_STEP
}
#undef VMW
#undef VMWN
#undef SLOAD_H
#undef SWRITE_HK
#undef SWRITE_HV
#undef SWRITE_H
#undef KSWZ
#undef SBAR
}


constexpr int NWAVES = 8;
#ifndef MK_PER_PHASE
#define MK_PER_PHASE 0
#endif

constexpr int BATCH = 2, SEQ = 8192, DM = 2048, FF = 5632, PLE = 256, DEPTH = 4, HD = 128;
constexpr int M = BATCH * SEQ;
constexpr int NA = 5120, NB = 6144, NC = 6144;
constexpr float RMS_EPS = 1e-6f, SUBLN_EPS = 1e-5f;
constexpr int N_PHASES = 41;

constexpr size_t MiB = 1u << 20;
constexpr size_t WS_CTL = 0, CTL_ZERO_BYTES = 1 * MiB;
constexpr size_t WS_SSQ0 = 1 * MiB, WS_SSQ1 = 3 * MiB;
constexpr size_t WS_LSE = 5 * MiB;
constexpr size_t WS_H = 8 * MiB;
constexpr size_t WS_HB0 = 136 * MiB, WS_HB1 = 200 * MiB;
constexpr size_t WS_BIG = 264 * MiB;
constexpr size_t WS_AO = 456 * MiB;
constexpr size_t WS_OT = 520 * MiB;
constexpr size_t WS_PB = 712 * MiB;
constexpr size_t WS_W = 744 * MiB;
constexpr size_t WL_FFN1_IN = 0, WL_FFN1_OUT = WL_FFN1_IN + (size_t)2 * FF * DM, WL_FFN2_IN = WL_FFN1_OUT + (size_t)DM * FF, WL_FFN2_OUT = WL_FFN2_IN + (size_t)2 * FF * DM,
                 WL_PLE_G = WL_FFN2_OUT + (size_t)DM * FF, WL_PLE_P = WL_PLE_G + (size_t)DM * DM, WL_MIX_IN = WL_PLE_P + (size_t)DM * PLE, WL_MIX_OUT = WL_MIX_IN + (size_t)6144 * DM,
                 WL_SIZE = WL_MIX_OUT + (size_t)DM * DM;
constexpr size_t WS_END = WS_W + (size_t)DEPTH * WL_SIZE * 2;
constexpr int CW_BAR = 4096;

constexpr int RING_OFF = 0, RING_BYTES = 131072;
constexpr int LDSCTL_OFF = RING_BYTES, MISC_OFF = LDSCTL_OFF + 320;
constexpr int RSTD_OFF = RING_BYTES + 1024;
constexpr int LDS_BYTES = 147456;
static_assert(MISC_OFF + 128 <= RSTD_OFF && RSTD_OFF + 1024 <= LDS_BYTES, "LDS map");

#define GAS __attribute__((address_space(1)))
#define LAS __attribute__((address_space(3)))
typedef unsigned short bf16;
typedef unsigned v4u __attribute__((ext_vector_type(4)));
typedef float f32x4 __attribute__((ext_vector_type(4)));
typedef short bf16x8 __attribute__((ext_vector_type(8)));
typedef GAS unsigned gu32;
typedef GAS unsigned long long gu64;
#define RLX_AGENT __ATOMIC_RELAXED, __HIP_MEMORY_SCOPE_AGENT
#define LDS_WAIT() asm volatile("s_waitcnt lgkmcnt(0)" ::: "memory")
#define VM_WAIT() asm volatile("s_waitcnt vmcnt(0)" ::: "memory")
__device__ __forceinline__ unsigned long long rt() { return __builtin_amdgcn_s_memrealtime(); }
__device__ __forceinline__ unsigned f2bf(float f) { unsigned u = __builtin_bit_cast(unsigned, f); return (u + 0x7fffu + ((u >> 16) & 1u)) >> 16; }
__device__ __forceinline__ unsigned pk2(float lo, float hi) { return f2bf(lo) | (f2bf(hi) << 16); }

#define XB_TMO      128
#define XB_XCNT(j)  (256  + 64 * (j))
#define XB_XSUB(j)  (1280 + 64 * (j))
#define XB_XGEN(j)  (2304 + 64 * (j))
#define XB_TOP      3328
#define XB_TOPGEN   3392
#define XCD_BAR_WORDS 3456
#define XB_SPIN_CAP (1u << 18)

__device__ __forceinline__ unsigned xb_ld(unsigned* p)              { return __hip_atomic_load(p, __ATOMIC_RELAXED, __HIP_MEMORY_SCOPE_AGENT); }
__device__ __forceinline__ unsigned xb_add(unsigned* p, unsigned v) { return __hip_atomic_fetch_add(p, v, __ATOMIC_RELAXED, __HIP_MEMORY_SCOPE_AGENT); }
__device__ __forceinline__ unsigned xb_xcc_id() { return (unsigned)__builtin_amdgcn_s_getreg((3 << 11) | 20) & 0xFu; }
#define XB_SPIN(cond, bar) do { unsigned _sp = 0; while (cond) { __builtin_amdgcn_s_sleep(1); \
    if ((++_sp & 255u) == 0u) { if (xb_ld(&(bar)[XB_TMO])) break; if (_sp > XB_SPIN_CAP) { atomicAdd(&(bar)[XB_TMO], 1u); break; } } } } while (0)

struct XcdBarrier {
    unsigned* bar; unsigned x;
    volatile LAS unsigned* st;
};

__device__ __forceinline__ XcdBarrier xcd_barrier_post(unsigned* bar, volatile LAS unsigned* st) {
    XcdBarrier b; b.bar = bar; b.x = xb_xcc_id(); b.st = st;
    if (threadIdx.x == 0) (void)xb_add(&bar[XB_XCNT(b.x)], 1u);
    return b;
}
__device__ __forceinline__ void xcd_barrier_complete(unsigned* bar, unsigned x, unsigned& nloc, unsigned& nx) {
    const unsigned G = gridDim.x * gridDim.y * gridDim.z;
    unsigned sum, cnt, mine, sp = 0u;
    for (;;) {
        sum = 0u; cnt = 0u; mine = 0u;
#pragma unroll
        for (unsigned j = 0; j < 16; ++j) { const unsigned c = xb_ld(&bar[XB_XCNT(j)]); sum += c; cnt += (c > 0u) ? 1u : 0u; mine = (j == x) ? c : mine; }
        if (sum == G) break;
        __builtin_amdgcn_s_sleep(1);
        if ((++sp & 255u) == 0u) { if (xb_ld(&bar[XB_TMO])) break; if (sp > XB_SPIN_CAP) { atomicAdd(&bar[XB_TMO], 1u); break; } }
    }
    nloc = mine > 0u ? mine : 1u; nx = cnt > 0u ? cnt : 1u;
}

__device__ __forceinline__ void xcd_barrier(const XcdBarrier& b) {
    asm volatile("s_waitcnt vmcnt(0)" ::: "memory");
    __syncthreads();
    if (threadIdx.x == 0) {
        unsigned* bar = b.bar;
        __builtin_amdgcn_s_waitcnt(0);
        unsigned nloc = b.st[0], nx = b.st[1];
        if (nloc == 0u) { xcd_barrier_complete(bar, b.x, nloc, nx); b.st[0] = nloc; b.st[1] = nx; }
        const unsigned old = xb_add(&bar[XB_XSUB(b.x)], 1u);
        const unsigned gen = old / nloc;
        if (old + 1u == (gen + 1u) * nloc) {
            __builtin_amdgcn_fence(__ATOMIC_RELEASE, "agent");
            asm volatile("s_waitcnt vmcnt(0)" ::: "memory");
            const unsigned og = xb_add(&bar[XB_TOP], 1u);
            const unsigned tg = og / nx;
            if (og + 1u == (tg + 1u) * nx) xb_add(&bar[XB_TOPGEN], 1u);
            else XB_SPIN(xb_ld(&bar[XB_TOPGEN]) == tg, bar);
            __builtin_amdgcn_fence(__ATOMIC_ACQUIRE, "agent");
            xb_add(&bar[XB_XGEN(b.x)], 1u);
            asm volatile("s_waitcnt vmcnt(0)" ::: "memory");
        } else {
            XB_SPIN(xb_ld(&bar[XB_XGEN(b.x)]) == gen, bar);
            __builtin_amdgcn_fence(__ATOMIC_ACQUIRE, "agent");
            asm volatile("s_waitcnt vmcnt(0)" ::: "memory");
        }
    }
    __syncthreads();
}

typedef __hip_bfloat16 bf16h;
struct Args { const float* in[23]; float* out; unsigned char* ws; int ph_lo, ph_hi; };

__device__ __forceinline__ float wave_sum(float v) {
#pragma unroll
    for (int o = 1; o < 64; o <<= 1) v += __shfl_xor(v, o);
    return v;
}
__device__ __forceinline__ float bflo(unsigned w) { return __uint_as_float(w << 16); }
__device__ __forceinline__ float bfhi(unsigned w) { return __uint_as_float(w & 0xffff0000u); }
__device__ __forceinline__ unsigned cvtpk2(float lo, float hi) { unsigned r; asm volatile("v_cvt_pk_bf16_f32 %0, %1, %2" : "=v"(r) : "v"(lo), "v"(hi)); return r; }

constexpr int CTX_OFF = RING_BYTES + 2048;
__device__ __forceinline__ unsigned char* ctxp(LAS unsigned char* ldsl, int i) {
    const unsigned long long v = *(volatile LAS unsigned long long*)(ldsl + CTX_OFF + 8 * i);
    const unsigned long long u = ((unsigned long long)(unsigned)__builtin_amdgcn_readfirstlane((int)(v >> 32)) << 32) | (unsigned long long)(unsigned)__builtin_amdgcn_readfirstlane((int)(unsigned)v);
    return (unsigned char*)(GAS unsigned char*)u;
}
__device__ __forceinline__ int map_row(int n, int mode) {
    if (mode == 1) { const int half = n >= FF ? 1 : 0, j = n - half * FF; return (j >> 7) * 256 + half * 128 + (j & 127); }
    if (mode == 2) { if (n < DM) return 2 * DM + n; const int half = n >= 2 * DM ? 1 : 0, j = n - DM - half * DM; return (j >> 7) * 256 + half * 128 + (j & 127); }
    return n;
}
__device__ __forceinline__ void p0_transpose_item(const float* W, const float* gain, int K, int N, bf16* WT, int mode, LAS float* scr, int item, int lane) {
    const int nblk = N / 32, kb = item / nblk, nb = item % nblk, k0 = 64 * kb, n0 = 32 * nb, d0 = map_row(n0, mode);
#pragma unroll 8
    for (int i = 0; i < 32; ++i) { const int kk = 2 * i + (lane >> 5); float v = W[(size_t)(k0 + kk) * N + n0 + (lane & 31)]; if (gain) v *= gain[k0 + kk]; scr[kk * 33 + (lane & 31)] = v; }
    LDS_WAIT(); asm volatile("" ::: "memory");
    const int c = lane & 7;
#pragma unroll
    for (int j = 0; j < 4; ++j) { const int n = (lane >> 3) + 8 * j; const LAS float* s = scr + (8 * c) * 33 + n;
        v4u o; o.x = pk2(s[0 * 33], s[1 * 33]); o.y = pk2(s[2 * 33], s[3 * 33]); o.z = pk2(s[4 * 33], s[5 * 33]); o.w = pk2(s[6 * 33], s[7 * 33]);
        *(GAS v4u*)(WT + (size_t)(d0 + n) * K + k0 + 8 * c) = o; }
    LDS_WAIT(); asm volatile("" ::: "memory");
}
struct WJob { const float* W; const float* gain; bf16* dst; int K, N, mode; };
#define CTX_IN(i) ((const float*)ctxp(ldsl, (i)))
__device__ __forceinline__ WJob get_job(LAS unsigned char* ldsl, int j) {
    const int l = j >> 3, t = j & 7, kind = l % 3, jj = l / 3; bf16* wl = (bf16*)(ctxp(ldsl, 24) + WS_W) + (size_t)l * WL_SIZE; WJob r;
    if (t == 0)      { r.W = CTX_IN(3) + (size_t)l * DM * 2 * FF;  r.gain = CTX_IN(2) + l * DM;  r.dst = wl + WL_FFN1_IN;  r.K = DM;  r.N = 2 * FF; r.mode = 1; }
    else if (t == 1) { r.W = CTX_IN(4) + (size_t)l * FF * DM;      r.gain = nullptr;           r.dst = wl + WL_FFN1_OUT; r.K = FF;  r.N = DM;     r.mode = 0; }
    else if (t == 2) { r.W = CTX_IN(16) + (size_t)l * DM * 2 * FF; r.gain = CTX_IN(15) + l * DM; r.dst = wl + WL_FFN2_IN;  r.K = DM;  r.N = 2 * FF; r.mode = 1; }
    else if (t == 3) { r.W = CTX_IN(17) + (size_t)l * FF * DM;     r.gain = nullptr;           r.dst = wl + WL_FFN2_OUT; r.K = FF;  r.N = DM;     r.mode = 0; }
    else if (t == 4) { r.W = CTX_IN(19) + (size_t)l * DM * DM;     r.gain = CTX_IN(18) + l * DM; r.dst = wl + WL_PLE_G;    r.K = DM;  r.N = DM;     r.mode = 0; }
    else if (t == 5) { r.W = CTX_IN(21) + (size_t)l * PLE * DM;    r.gain = nullptr;           r.dst = wl + WL_PLE_P;    r.K = PLE; r.N = DM;     r.mode = 0; }
    else if (t == 6) { r.gain = CTX_IN(5) + l * DM; r.dst = wl + WL_MIX_IN; r.K = DM;
        if (kind == 0)      { r.W = CTX_IN(6) + (size_t)jj * DM * NA;  r.N = NA; r.mode = 0; }
        else if (kind == 1) { r.W = CTX_IN(8) + (size_t)jj * DM * NB;  r.N = NB; r.mode = 0; }
        else                { r.W = CTX_IN(12) + (size_t)jj * DM * NC; r.N = NC; r.mode = 2; } }
    else { r.gain = nullptr; r.dst = wl + WL_MIX_OUT; r.K = DM; r.N = DM; r.mode = 0;
        r.W = (kind == 0 ? CTX_IN(7) : (kind == 1 ? CTX_IN(9) : CTX_IN(14))) + (size_t)jj * DM * DM; }
    return r;
}
__device__ __forceinline__ void p0_prologue(LAS unsigned char* ldsl, int wave, int lane, int G) {
    LAS unsigned char* lds = ldsl; unsigned char* wsb = ctxp(ldsl, 24);
    LAS float* scr = (LAS float*)(lds + RING_OFF + wave * 16384);
    const int gw = (int)blockIdx.x * NWAVES + wave, NGW = G * NWAVES;
    long base = 0;
    for (int j = 0; j < 8 * DEPTH; ++j) {
        const WJob jb = get_job(ldsl, j); const int nitems = (jb.K / 64) * (jb.N / 32);
        int start = (int)(((long)gw - base) % NGW); if (start < 0) start += NGW;
        for (int it = start; it < nitems; it += NGW) p0_transpose_item(jb.W, jb.gain, jb.K, jb.N, jb.dst, jb.mode, scr, it, lane);
        base += nitems;
    }
    float* H = (float*)(wsb + WS_H); bf16* HB = (bf16*)(wsb + WS_HB0); float* SSQ = (float*)(wsb + WS_SSQ0); const float* xin = CTX_IN(0);
    for (int m = gw; m < M; m += NGW) {
        const GAS f32x4* xr = (const GAS f32x4*)(xin + (size_t)m * DM) + lane; GAS f32x4* hr = (GAS f32x4*)(H + (size_t)m * DM) + lane;
        GAS unsigned long long* o8 = (GAS unsigned long long*)(HB + (size_t)m * DM) + lane; float s = 0.f;
#pragma unroll
        for (int j = 0; j < 8; ++j) { const f32x4 v = xr[64 * j]; hr[64 * j] = v; s += (v.x * v.x + v.y * v.y) + (v.z * v.z + v.w * v.w);
            o8[64 * j] = (unsigned long long)pk2(v.x, v.y) | ((unsigned long long)pk2(v.z, v.w) << 32); }
        s = wave_sum(s);
        if (lane < 32) SSQ[(size_t)m * 32 + lane] = lane == 0 ? s : 0.f;
    }
    { const GAS f32x4* p4 = (const GAS f32x4*)CTX_IN(1); GAS v4u* o = (GAS v4u*)(wsb + WS_PB); const long nch = (long)DEPTH * M * PLE / 8;
      for (long i = (long)gw * 64 + lane; i < nch; i += (long)NGW * 64) { const f32x4 v0 = p4[2 * i], v1 = p4[2 * i + 1]; v4u w; w.x = pk2(v0.x, v0.y); w.y = pk2(v0.z, v0.w); w.z = pk2(v1.x, v1.y); w.w = pk2(v1.z, v1.w); o[i] = w; } }
}

__device__ __forceinline__ void rstd_table(const float* ssq, int pm, LAS float* tab, int tid) {
    if (tid < 256) { const f32x4* p = (const f32x4*)(ssq + (size_t)(pm * 256 + tid) * 32); f32x4 s = p[0];
#pragma unroll
        for (int k = 1; k < 8; ++k) s += p[k];
        tab[tid] = 1.0f / sqrtf(((s[0] + s[1]) + (s[2] + s[3])) * (1.0f / DM) + RMS_EPS); }
    __syncthreads();
}

__device__ __forceinline__ swa::BlockRef a_ref(int n, int c, const bf16h* QKV, bf16h* OT, float* LSE) {
    const int g = n >> 2, hq = n & 3, dil = g == 0 ? 1 : (g == 1 ? 4 : 16), nqb = 32 / dil;
    int idx = c; const int qb = idx % nqb; idx /= nqb; const int kvh = idx & 3; idx >>= 2; const int r = idx % dil, b = idx / dil;
    const int h = kvh * 4 + hq; const size_t row0 = (size_t)b * SEQ + r, rowq = row0 + (size_t)dil * 256 * qb;
    swa::BlockRef R; R.Q = QKV + rowq * NA + h * HD; R.K = QKV + row0 * NA + DM + ((g * 2 + 0) * 4 + kvh) * HD; R.V = QKV + row0 * NA + DM + ((g * 2 + 1) * 4 + kvh) * HD;
    R.O = OT + (size_t)g * M * DM + rowq * DM + h * HD; R.L = LSE + (size_t)g * M * 16 + rowq * 16 + h; R.P0 = 256 * qb; R.skv = SEQ / dil; R.qs = dil * NA; R.kvs = dil * NA; R.os = dil * DM; R.ls = dil * 16;
    return R;
}
__device__ __forceinline__ swa::BlockRef b_ref(int n, int c, const bf16h* QKV, bf16h* OT) {
    const int x = c & 7, j = c >> 3, it = n >> 1, pass = n & 1, combo = x * 8 + 2 * it + (j >> 4), y = j & 15, qb = pass ? 31 - y : y;
    const int vhalf = combo & 1, cc = (combo >> 1) & 1, h = (combo >> 2) & 7, b = combo >> 5; const size_t row0 = (size_t)b * SEQ, rowq = row0 + 256 * qb;
    swa::BlockRef R; R.Q = QKV + rowq * NB + h * 256 + cc * HD; R.K = QKV + row0 * NB + DM + h * 256 + cc * HD; R.V = QKV + row0 * NB + 2 * DM + h * 256 + vhalf * HD;
    R.O = OT + rowq * (2 * DM) + (h * 4 + cc * 2 + vhalf) * HD; R.L = nullptr; R.P0 = 256 * qb; R.skv = SEQ; R.qs = NB; R.kvs = NB; R.os = 2 * DM; R.ls = 0;
    return R;
}

__global__ void __launch_bounds__(NWAVES * 64, 2) mk_fwd(Args args) {
    extern __shared__ __attribute__((aligned(16))) unsigned char lds[];
    LAS unsigned char* ldsl = (LAS unsigned char*)lds;
    volatile LAS unsigned* MISC = (volatile LAS unsigned*)(ldsl + MISC_OFF);
    LAS float* rstab = (LAS float*)(ldsl + RSTD_OFF);
    const int tid0 = threadIdx.x;
#define PHASE_IDS() int tid = threadIdx.x, cwg = blockIdx.x; asm volatile("" : "+v"(tid), "+s"(cwg)); const int lane = tid & 63, wave = __builtin_amdgcn_readfirstlane(tid >> 6), G = gridDim.x, \
        gw = cwg * NWAVES + wave, NGW = G * NWAVES, my_pm = (cwg & 7) * 8 + ((cwg >> 3) & 7); (void)lane; (void)gw; (void)NGW; (void)my_pm
    for (int u = tid0; u < (LDS_BYTES - LDSCTL_OFF) / 4; u += NWAVES * 64) ((LAS unsigned*)(ldsl + LDSCTL_OFF))[u] = 0u;
    __syncthreads();
    if (tid0 == 0) { LAS unsigned long long* cx = (LAS unsigned long long*)(ldsl + CTX_OFF);
#pragma unroll
        for (int i = 0; i < 23; ++i) cx[i] = (unsigned long long)(uintptr_t)args.in[i];
        cx[23] = (unsigned long long)(uintptr_t)args.out; cx[24] = (unsigned long long)(uintptr_t)args.ws; }
    __syncthreads();
    if (!MK_PER_PHASE) (void)xcd_barrier_post((unsigned*)(ctxp(ldsl, 24) + WS_CTL) + CW_BAR, MISC + 8);
    const int lo = args.ph_lo, hi = args.ph_hi;
    int ph = 0, par = 0;
#define IN_() (lo <= ph && ph < hi)
#define SEAM() do { if (!MK_PER_PHASE && lo <= ph && ph + 1 < hi) { XcdBarrier b_; b_.bar = (unsigned*)(ctxp(ldsl, 24) + WS_CTL) + CW_BAR; b_.x = xb_xcc_id(); b_.st = MISC + 8; xcd_barrier(b_); } ++ph; } while (0)
#define WSP() ctxp(ldsl, 24)

    if (IN_()) { PHASE_IDS(); p0_prologue(ldsl, wave, lane, G); }
    SEAM();

    for (int pr = 0; pr < 4 * DEPTH; ++pr) {
        const int l = pr >> 2, sub = pr & 3, kind = l % 3, jj = l / 3;
        if (IN_()) {
            PHASE_IDS();
            unsigned char* ws = WSP(); bf16h* BIG = (bf16h*)(ws + WS_BIG); bf16h* OT = (bf16h*)(ws + WS_OT);
            const pg8::bf16_t* wl = (const pg8::bf16_t*)(ws + WS_W) + (size_t)l * WL_SIZE;
            const pg8::bf16_t* hb_cur = (const pg8::bf16_t*)(ws + (par ? WS_HB1 : WS_HB0));
            const float* ssq_cur = (const float*)(ws + (par ? WS_SSQ1 : WS_SSQ0));
            pg8::Gemm g; pg8::XEpi E; g.M = M; E.rs = rstab; E.use_rstd = 1; E.act = 0; E.nglu = 0; E.O1 = (pg8::bf16_t*)BIG; E.ld1 = FF; E.O2 = (pg8::bf16_t*)BIG; E.ld2 = DM;
            if (sub == 0 || sub == 2) { g.A = hb_cur; g.Bt = wl + (sub == 0 ? WL_FFN1_IN : WL_FFN2_IN); g.N = 2 * FF; g.K = DM; E.nglu = 2 * FF / 256; E.act = 1; }
            else if (sub == 1) { g.A = hb_cur; g.Bt = wl + WL_MIX_IN; g.K = DM;
                if (kind == 0) { g.N = NA; E.ld2 = NA; } else if (kind == 1) { g.N = NB; E.ld2 = NB; }
                else { g.N = NC; E.nglu = 16; E.O1 = (pg8::bf16_t*)OT; E.ld1 = DM; E.ld2 = DM; } }
            else { g.A = (const pg8::bf16_t*)(ws + WS_PB) + (size_t)l * M * PLE; g.Bt = wl + WL_PLE_P; g.N = DM; g.K = PLE; E.use_rstd = 0; E.O2 = (pg8::bf16_t*)OT; E.ld2 = DM; }
            if (E.use_rstd) rstd_table(ssq_cur, my_pm, rstab, tid);
            pg8::PanelOrder S; S.init(g.N, G, cwg);
            pg8::gemm_phase<pg8::XEpi, pg8::PanelOrder, true, true>(ldsl + RING_OFF, g, S, E);
        }
        SEAM();
        if (sub == 1) {
            if (kind == 0) {
                if (IN_()) {
                    PHASE_IDS();
                    unsigned char* ws = WSP(); const bf16h* BIG = (const bf16h*)(ws + WS_BIG); bf16h* OT = (bf16h*)(ws + WS_OT); float* LSE = (float*)(ws + WS_LSE);
                    swa::Seam S; swa::BlockRef cur = a_ref(0, cwg, BIG, OT, LSE), nxt;
                    swa::causal_swa_prime(cur, 129, (char*)lds + RING_OFF, S);
                    for (int n = 0; n < 12; ++n) { nxt = (n < 11) ? a_ref(n + 1, cwg, BIG, OT, LSE) : cur; swa::causal_swa_block<true>(cur, nxt, 129, (char*)lds + RING_OFF, S); cur = nxt; }
                }
                SEAM();
                if (IN_()) {
                    PHASE_IDS();
                    unsigned char* ws = WSP(); const bf16h* OT = (const bf16h*)(ws + WS_OT); bf16h* AO = (bf16h*)(ws + WS_AO); const float* LSE = (const float*)(ws + WS_LSE);
                    for (int m = gw; m < M; m += NGW) {
#pragma unroll
                        for (int j = 0; j < 4; ++j) { const int c = lane + 64 * j, head = c >> 4;
                            const float l0 = LSE[(size_t)m * 16 + head], l1 = LSE[(size_t)(M + m) * 16 + head], l2 = LSE[(size_t)(2 * M + m) * 16 + head];
                            const float mx = fmaxf(l0, fmaxf(l1, l2)); float w0 = __builtin_amdgcn_exp2f(l0 - mx), w1 = __builtin_amdgcn_exp2f(l1 - mx), w2 = __builtin_amdgcn_exp2f(l2 - mx);
                            const float inv = 1.0f / (w0 + w1 + w2); w0 *= inv; w1 *= inv; w2 *= inv;
                            const v4u a = *(const v4u*)(OT + (size_t)m * DM + 8 * c), b = *(const v4u*)(OT + (size_t)(M + m) * DM + 8 * c), d = *(const v4u*)(OT + (size_t)(2 * M + m) * DM + 8 * c);
                            v4u o;
                            o.x = cvtpk2(w0 * bflo(a.x) + w1 * bflo(b.x) + w2 * bflo(d.x), w0 * bfhi(a.x) + w1 * bfhi(b.x) + w2 * bfhi(d.x));
                            o.y = cvtpk2(w0 * bflo(a.y) + w1 * bflo(b.y) + w2 * bflo(d.y), w0 * bfhi(a.y) + w1 * bfhi(b.y) + w2 * bfhi(d.y));
                            o.z = cvtpk2(w0 * bflo(a.z) + w1 * bflo(b.z) + w2 * bflo(d.z), w0 * bfhi(a.z) + w1 * bfhi(b.z) + w2 * bfhi(d.z));
                            o.w = cvtpk2(w0 * bflo(a.w) + w1 * bflo(b.w) + w2 * bflo(d.w), w0 * bfhi(a.w) + w1 * bfhi(b.w) + w2 * bfhi(d.w));
                            *(v4u*)(AO + (size_t)m * DM + 8 * c) = o; }
                    }
                }
                SEAM();
            } else if (kind == 1) {
                if (IN_()) {
                    PHASE_IDS();
                    unsigned char* ws = WSP(); const bf16h* BIG = (const bf16h*)(ws + WS_BIG); bf16h* OT = (bf16h*)(ws + WS_OT);
                    swa::Seam S; swa::BlockRef cur = b_ref(0, cwg, BIG, OT), nxt;
                    swa::causal_swa_prime(cur, SEQ, (char*)lds + RING_OFF, S);
                    for (int n = 0; n < 8; ++n) { nxt = (n < 7) ? b_ref(n + 1, cwg, BIG, OT) : cur; swa::causal_swa_block<false>(cur, nxt, SEQ, (char*)lds + RING_OFF, S); cur = nxt; }
                }
                SEAM();
                if (IN_()) {
                    PHASE_IDS();
                    unsigned char* ws = WSP(); const bf16h* OT = (const bf16h*)(ws + WS_OT); bf16h* AO = (bf16h*)(ws + WS_AO);
                    const float* lp = CTX_IN(10) + (size_t)jj * 4 * HD; const float* sg = CTX_IN(11) + (size_t)jj * 2 * HD;
                    float s1 = lp[lane] * lp[HD + lane] + lp[64 + lane] * lp[HD + 64 + lane], s2 = lp[2 * HD + lane] * lp[3 * HD + lane] + lp[2 * HD + 64 + lane] * lp[3 * HD + 64 + lane];
                    s1 = wave_sum(s1); s2 = wave_sum(s2);
                    const float lam_init = 0.8f - 0.6f * expf(-0.3f * (float)l), lam = expf(s1) - expf(s2) + lam_init, post = 1.0f - lam_init;
                    for (int m = gw; m < M; m += NGW) {
#pragma unroll
                        for (int j = 0; j < 4; ++j) { const int oc = 8 * (lane + 64 * j), h = oc >> 8, jc = oc & 255;
                            const v4u a = *(const v4u*)(OT + (size_t)m * (2 * DM) + h * 512 + jc), b = *(const v4u*)(OT + (size_t)m * (2 * DM) + h * 512 + 256 + jc);
                            float d[8]; d[0] = bflo(a.x) - lam * bflo(b.x); d[1] = bfhi(a.x) - lam * bfhi(b.x); d[2] = bflo(a.y) - lam * bflo(b.y); d[3] = bfhi(a.y) - lam * bfhi(b.y);
                            d[4] = bflo(a.z) - lam * bflo(b.z); d[5] = bfhi(a.z) - lam * bfhi(b.z); d[6] = bflo(a.w) - lam * bflo(b.w); d[7] = bfhi(a.w) - lam * bfhi(b.w);
                            float ss = (d[0] * d[0] + d[1] * d[1]) + (d[2] * d[2] + d[3] * d[3]) + (d[4] * d[4] + d[5] * d[5]) + (d[6] * d[6] + d[7] * d[7]);
                            ss += __shfl_xor(ss, 1); ss += __shfl_xor(ss, 2); ss += __shfl_xor(ss, 4); ss += __shfl_xor(ss, 8); ss += __shfl_xor(ss, 16);
                            const float r = post / sqrtf(ss * (1.0f / 256.0f) + SUBLN_EPS);
                            const f32x4 g0 = *(const f32x4*)(sg + jc), g1 = *(const f32x4*)(sg + jc + 4);
                            v4u o; o.x = cvtpk2(d[0] * r * g0.x, d[1] * r * g0.y); o.y = cvtpk2(d[2] * r * g0.z, d[3] * r * g0.w); o.z = cvtpk2(d[4] * r * g1.x, d[5] * r * g1.y); o.w = cvtpk2(d[6] * r * g1.z, d[7] * r * g1.w);
                            *(v4u*)(AO + (size_t)m * DM + oc) = o; }
                    }
                }
                SEAM();
            } else {
                if (IN_()) { PHASE_IDS();
                    unsigned char* ws = WSP(); const bf16h* OT = (const bf16h*)(ws + WS_OT); const bf16h* BIG = (const bf16h*)(ws + WS_BIG); bf16h* AO = (bf16h*)(ws + WS_AO);
                    const float* cw = CTX_IN(13) + (size_t)jj * 3 * DM;
                    for (int m = gw; m < M; m += NGW) { const int t = m & (SEQ - 1);
#pragma unroll
                        for (int j = 0; j < 4; ++j) { const int col = 8 * (lane + 64 * j);
                            const v4u z0 = *(const v4u*)(OT + (size_t)m * DM + col); v4u z1 = {0u, 0u, 0u, 0u}, z2 = {0u, 0u, 0u, 0u};
                            if (t >= 1) z1 = *(const v4u*)(OT + (size_t)(m - 1) * DM + col);
                            if (t >= 2) z2 = *(const v4u*)(OT + (size_t)(m - 2) * DM + col);
                            const v4u bg = *(const v4u*)(BIG + (size_t)m * DM + col);
                            const f32x4 wa0 = *(const f32x4*)(cw + col), wa1 = *(const f32x4*)(cw + col + 4), wb0 = *(const f32x4*)(cw + DM + col), wb1 = *(const f32x4*)(cw + DM + col + 4),
                                        wc0 = *(const f32x4*)(cw + 2 * DM + col), wc1 = *(const f32x4*)(cw + 2 * DM + col + 4);
                            v4u o;
                            o.x = cvtpk2(bflo(bg.x) * (wa0.x * bflo(z2.x) + wb0.x * bflo(z1.x) + wc0.x * bflo(z0.x)), bfhi(bg.x) * (wa0.y * bfhi(z2.x) + wb0.y * bfhi(z1.x) + wc0.y * bfhi(z0.x)));
                            o.y = cvtpk2(bflo(bg.y) * (wa0.z * bflo(z2.y) + wb0.z * bflo(z1.y) + wc0.z * bflo(z0.y)), bfhi(bg.y) * (wa0.w * bfhi(z2.y) + wb0.w * bfhi(z1.y) + wc0.w * bfhi(z0.y)));
                            o.z = cvtpk2(bflo(bg.z) * (wa1.x * bflo(z2.z) + wb1.x * bflo(z1.z) + wc1.x * bflo(z0.z)), bfhi(bg.z) * (wa1.y * bfhi(z2.z) + wb1.y * bfhi(z1.z) + wc1.y * bfhi(z0.z)));
                            o.w = cvtpk2(bflo(bg.w) * (wa1.z * bflo(z2.w) + wb1.z * bflo(z1.w) + wc1.z * bflo(z0.w)), bfhi(bg.w) * (wa1.w * bfhi(z2.w) + wb1.w * bfhi(z1.w) + wc1.w * bfhi(z0.w)));
                            *(v4u*)(AO + (size_t)m * DM + col) = o; }
                    }
                }
                SEAM();
            }
        }
        if (IN_()) {
            PHASE_IDS();
            unsigned char* ws = WSP(); float* H = (float*)(ws + WS_H); const bf16h* BIG = (const bf16h*)(ws + WS_BIG); const bf16h* AO = (const bf16h*)(ws + WS_AO); const bf16h* OT = (const bf16h*)(ws + WS_OT);
            const pg8::bf16_t* wl = (const pg8::bf16_t*)(ws + WS_W) + (size_t)l * WL_SIZE;
            const pg8::bf16_t* hb_cur = (const pg8::bf16_t*)(ws + (par ? WS_HB1 : WS_HB0));
            const float* ssq_cur = (const float*)(ws + (par ? WS_SSQ1 : WS_SSQ0));
            pg8::Gemm g; pg8::REpi E; g.M = M; g.N = DM; E.Hin = H; E.H = H; E.HB = (pg8::bf16_t*)(ws + (par ? WS_HB0 : WS_HB1)); E.SSQ = (float*)(ws + (par ? WS_SSQ0 : WS_SSQ1));
            E.scale = 1.f; E.mode = 0; E.PP = (const pg8::bf16_t*)OT; E.bias = CTX_IN(20) + (size_t)l * DM; E.rs = rstab;
            if (sub == 0 || sub == 2) { g.A = (const pg8::bf16_t*)BIG; g.Bt = wl + (sub == 0 ? WL_FFN1_OUT : WL_FFN2_OUT); g.K = FF; E.scale = 0.5f; }
            else if (sub == 1) { g.A = (const pg8::bf16_t*)AO; g.Bt = wl + WL_MIX_OUT; g.K = DM; }
            else { g.A = hb_cur; g.Bt = wl + WL_PLE_G; g.K = DM; E.mode = 1; }
            if (E.mode) rstd_table(ssq_cur, my_pm, rstab, tid);
            pg8::PanelOrder S; S.init(DM, G, cwg);
            pg8::gemm_phase<pg8::REpi, pg8::PanelOrder, true, true>(ldsl + RING_OFF, g, S, E);
        }
        par ^= 1;
        SEAM();
    }
    if (IN_()) {
        PHASE_IDS();
        unsigned char* ws = WSP(); const float* H = (const float*)(ws + WS_H); float* outp = (float*)ctxp(ldsl, 23);
        const float* ssq = (const float*)(ws + (par ? WS_SSQ1 : WS_SSQ0)); const float* gf = CTX_IN(22);
        for (int m = gw; m < M; m += NGW) {
            float s = lane < 32 ? ssq[(size_t)m * 32 + lane] : 0.f; s = wave_sum(s);
            const float rstd = 1.0f / sqrtf(s * (1.0f / DM) + RMS_EPS);
            const GAS f32x4* hr = (const GAS f32x4*)(H + (size_t)m * DM) + lane; GAS f32x4* orow = (GAS f32x4*)(outp + (size_t)m * DM) + lane; const f32x4* g4 = (const f32x4*)gf + lane;
#pragma unroll
            for (int j = 0; j < 8; ++j) orow[64 * j] = hr[64 * j] * rstd * g4[64 * j];
        }
    }
#undef IN_
#undef SEAM
#undef WSP
#undef PHASE_IDS
}

extern "C" void kernel_launch(void* const* d_in, const int* in_sizes, int n_in, void* d_out, int out_size, void* d_ws, size_t ws_size, hipStream_t stream) {
    static int grid = 0;
    if (grid == 0) {
        if (n_in != 23 || in_sizes[0] != M * DM || out_size != M * DM || ws_size < WS_END) {
            fprintf(stderr, "kernel_launch: built for 23 inputs, x/out of %d floats, >= %zu bytes of workspace; got n_in %d, in0 %d, out %d, ws %zu; nothing launched\n", M * DM, (size_t)WS_END, n_in, n_in > 0 ? in_sizes[0] : -1, out_size, ws_size); grid = -1; return; }
        int dev = 0, cus = 0, per_cu = 0;
        if (hipGetDevice(&dev) != hipSuccess || hipDeviceGetAttribute(&cus, hipDeviceAttributeMultiprocessorCount, dev) != hipSuccess) { fprintf(stderr, "kernel_launch: hipGetDevice / hipDeviceGetAttribute failed\n"); grid = -1; return; }
        if (hipFuncSetAttribute((const void*)mk_fwd, hipFuncAttributeMaxDynamicSharedMemorySize, LDS_BYTES) != hipSuccess) { fprintf(stderr, "kernel_launch: hipFuncSetAttribute failed\n"); grid = -1; return; }
        if (hipOccupancyMaxActiveBlocksPerMultiprocessor(&per_cu, (const void*)mk_fwd, NWAVES * 64, LDS_BYTES) != hipSuccess || per_cu < 1)
            fprintf(stderr, "kernel_launch: note: occupancy query reports %d workgroups per CU\n", per_cu);
        (void)hipGetLastError();
        grid = 256;
        if (cus < 256) { fprintf(stderr, "kernel_launch: device has %d CUs; this kernel needs 256 resident workgroups; nothing launched\n", cus); grid = -1; return; }
    }
    if (grid < 0) return;
    if (hipMemsetAsync((char*)d_ws + WS_CTL, 0, CTL_ZERO_BYTES, stream) != hipSuccess) { fprintf(stderr, "kernel_launch: hipMemsetAsync failed\n"); return; }
    Args a{};
    for (int i = 0; i < 23; ++i) a.in[i] = (const float*)d_in[i];
    a.out = (float*)d_out; a.ws = (unsigned char*)d_ws;
#if MK_PER_PHASE
    for (int li = 0; li < N_PHASES; ++li) { a.ph_lo = li; a.ph_hi = li + 1; hipLaunchKernelGGL(mk_fwd, dim3(grid), dim3(NWAVES * 64), LDS_BYTES, stream, a); }
#else
    a.ph_lo = 0; a.ph_hi = N_PHASES;
    hipLaunchKernelGGL(mk_fwd, dim3(grid), dim3(NWAVES * 64), LDS_BYTES, stream, a);
#endif
    const hipError_t le = hipPeekAtLastError();
    if (le != hipSuccess) fprintf(stderr, "kernel_launch: launch failed: %s\n", hipGetErrorName(le));
}
```

```cpp
#include <hip/hip_runtime.h>
#include <hip/hip_bf16.h>
#include <cstdio>
#include <cstdint>
#include <cmath>
__device__ __forceinline__ float shx(float v, int mask, int lane) { return __builtin_bit_cast(float, __builtin_amdgcn_ds_bpermute((lane ^ mask) << 2, __builtin_bit_cast(int, v))); }
__device__ __forceinline__ int lane_id_v() { int l; asm volatile("v_mbcnt_lo_u32_b32 %0, -1, 0\n\tv_mbcnt_hi_u32_b32 %0, -1, %0" : "=v"(l)); return l; }
namespace pg8 {
#define PG8_LAS __attribute__((address_space(3)))
typedef unsigned short bf16_t;
typedef short bf16x8 __attribute__((ext_vector_type(8)));
typedef float f32x4 __attribute__((ext_vector_type(4)));
typedef unsigned u32x4 __attribute__((ext_vector_type(4)));
constexpr int BM = 256, BK = 64, HALF = 128, HTB = HALF * BK * 2  , STAGE_BYTES = 8 * HTB, NXCD = 8, WGM = 8;

__host__ __device__ __forceinline__ int lds_byte(int r, int c) { const int st = (r >> 4) * 2 + (c >> 5), rr = r & 15, cc = c & 31, ob = rr * 64 + cc * 2; return st * 1024 + (ob ^ (((ob >> 9) & 1) << 5)); }
__host__ __device__ __forceinline__ void stage_rc(int b, int& R, int& C) { const int st = b / 1024, sb = b % 1024, swz = sb ^ (((sb >> 9) & 1) << 5); R = (st >> 1) * 16 + swz / 64; C = (st & 1) * 32 + (swz % 64) / 2; }
__host__ __device__ __forceinline__ int perm32(int rho) { const int n = rho >> 4, i = rho & 15; return 8 * (i >> 2) + 4 * n + (i & 3); }

struct Unit { int pm, pn; };
struct Gemm { const bf16_t* A; const bf16_t* Bt; int M, N, K, lda; };

__device__ __forceinline__ unsigned cvt_pk_bf16(float lo, float hi) { unsigned r; asm volatile("v_cvt_pk_bf16_f32 %0, %1, %2" : "=v"(r) : "v"(lo), "v"(hi)); return r; }
typedef _Float16 h16x2 __attribute__((ext_vector_type(2)));
typedef _Float16 h16x8 __attribute__((ext_vector_type(8)));
typedef float f32x2c __attribute__((ext_vector_type(2)));
__device__ __forceinline__ unsigned cvt_pk_f16(float lo, float hi) { const f32x2c v = {lo, hi}; return __builtin_bit_cast(unsigned, __builtin_convertvector(v, h16x2)); }
__device__ __forceinline__ f32x2c unpk_f16(unsigned w) { return __builtin_convertvector(__builtin_bit_cast(h16x2, w), f32x2c); }

struct PanelOrder {
    int nunits, G, c;
    __host__ __device__ void init(int N, int G_, int c_) { nunits = 64 * (N / BM); G = G_; c = c_; }
    __host__ __device__ bool next(int i, Unit& u) const {
        const long L = (long)i * G + c; if (L >= nunits) return false;
        u.pm = (int)((L & 7) * 8 + ((L >> 3) & 7)); u.pn = (int)(L >> 6); return true;
    }
    __device__ __forceinline__ void a_ready(const Unit&) const {}
    __device__ __forceinline__ void done(const Unit&) const {}
};

__device__ __forceinline__ float sigmoid_f(float x) { return __builtin_amdgcn_rcpf(1.0f + __builtin_amdgcn_exp2f(-1.4426950408889634f * x)); }
__device__ __forceinline__ f32x4 silu4(f32x4 g) { f32x4 r; r[0] = g[0] * sigmoid_f(g[0]); r[1] = g[1] * sigmoid_f(g[1]); r[2] = g[2] * sigmoid_f(g[2]); r[3] = g[3] * sigmoid_f(g[3]); return r; }
__device__ __forceinline__ f32x4 sig4(f32x4 g) { f32x4 r; r[0] = sigmoid_f(g[0]); r[1] = sigmoid_f(g[1]); r[2] = sigmoid_f(g[2]); r[3] = sigmoid_f(g[3]); return r; }

constexpr int SSQ_ROWS = 16384, SSQ_DM = 2048; constexpr float SSQ_EPS = 1e-6f;
__device__ __forceinline__ void rstd_table_pre(const float* ssq, int pm, PG8_LAS float* tab, int tid) {
    if (ssq != nullptr && tid < 256) { const f32x4* p = (const f32x4*)(ssq + (size_t)(pm * 256 + tid) * 4); f32x4 s = p[0];
#pragma unroll
        for (int k = 1; k < 8; ++k) s += p[(size_t)k * SSQ_ROWS];
        tab[tid] = 1.0f / sqrtf(((s[0] + s[1]) + (s[2] + s[3])) * (1.0f / SSQ_DM) + SSQ_EPS); }
}

struct XEpi {
    static constexpr bool PERM = true, AFTER_DRAIN = false;
    bf16_t* O1; int ld1; bf16_t* O2; int ld2; int nglu; int act; int use_rstd; const PG8_LAS float* rs; const float* tssq; int tpm; PG8_LAS float* tw;
    __device__ __forceinline__ void pre(int tid) const { rstd_table_pre(tssq, tpm, tw, tid); }
    __device__ __forceinline__ void operator()(const f32x4 (&acc)[2][2][4][2], const Unit& u, int wr, int wc, int fr, int fq) const {
        asm volatile("" : "+v"(fr), "+v"(fq));
        const int rl0 = wr * 64 + fr;
        if (u.pn < nglu) {
            bf16_t* base = O1 + (size_t)(u.pm * BM) * ld1 + u.pn * 128 + wc * 32 + 8 * fq;
#pragma unroll
            for (int ai = 0; ai < 2; ++ai)
#pragma unroll
                for (int m = 0; m < 4; ++m) { const int rl = rl0 + ai * HALF + m * 16; const float s = use_rstd ? rs[rl] : 1.f;
                    f32x4 g0 = acc[ai][0][m][0] * s, g1 = acc[ai][0][m][1] * s; const f32x4 u0 = acc[ai][1][m][0] * s, u1 = acc[ai][1][m][1] * s;
                    if (act) { g0 = silu4(g0); g1 = silu4(g1); }
                    const f32x4 v0 = g0 * u0, v1 = g1 * u1;
                    u32x4 w; w.x = cvt_pk_bf16(v0[0], v0[1]); w.y = cvt_pk_bf16(v0[2], v0[3]); w.z = cvt_pk_bf16(v1[0], v1[1]); w.w = cvt_pk_bf16(v1[2], v1[3]);
                    *(u32x4*)(base + (size_t)rl * ld1) = w; }
        } else {
            bf16_t* base = O2 + (size_t)(u.pm * BM) * ld2 + (u.pn - nglu) * BM + wc * 32 + 8 * fq;
#pragma unroll
            for (int ai = 0; ai < 2; ++ai)
#pragma unroll
                for (int m = 0; m < 4; ++m) { const int rl = rl0 + ai * HALF + m * 16; const float s = use_rstd ? rs[rl] : 1.f;
#pragma unroll
                    for (int bj = 0; bj < 2; ++bj) { const f32x4 v0 = acc[ai][bj][m][0] * s, v1 = acc[ai][bj][m][1] * s;
                        u32x4 w; w.x = cvt_pk_bf16(v0[0], v0[1]); w.y = cvt_pk_bf16(v0[2], v0[3]); w.z = cvt_pk_bf16(v1[0], v1[1]); w.w = cvt_pk_bf16(v1[2], v1[3]);
                        *(u32x4*)(base + (size_t)rl * ld2 + bj * HALF) = w; } }
        }
    }
};

struct REpi {
    static constexpr bool PERM = true, AFTER_DRAIN = false;
    bf16_t* H16; const bf16_t* HBin; int rd16, wr16  ; bf16_t* HB; float* SSQ; float scale; int mode; const bf16_t* PP; const float* bias; const PG8_LAS float* rs; const float* tssq; int tpm; PG8_LAS float* tw;
    __device__ __forceinline__ void pre(int tid) const { rstd_table_pre(tssq, tpm, tw, tid); }
    __device__ __forceinline__ void operator()(const f32x4 (&acc)[2][2][4][2], const Unit& u, int wr, int wc, int fr, int fq) const {
        asm volatile("" : "+v"(fr), "+v"(fq));
        constexpr int LD = 2048;
        const int rl0 = wr * 64 + fr, col0 = u.pn * BM + wc * 32 + 8 * fq;
        f32x4 bv[2][2];
#pragma unroll
        for (int bj = 0; bj < 2; ++bj)
#pragma unroll
            for (int n = 0; n < 2; ++n) bv[bj][n] = mode ? *(const f32x4*)(bias + col0 + bj * HALF + 4 * n) : (f32x4){0.f, 0.f, 0.f, 0.f};
        u32x4 hh[2][4][2];
#pragma unroll
        for (int ai = 0; ai < 2; ++ai)
#pragma unroll
            for (int m = 0; m < 4; ++m) { const size_t off = (size_t)(u.pm * BM + rl0 + ai * HALF + m * 16) * LD + col0;
#pragma unroll
                for (int bj = 0; bj < 2; ++bj) hh[ai][m][bj] = rd16 ? *(const u32x4*)(H16 + off + bj * HALF) : *(const u32x4*)(HBin + off + bj * HALF); }
#pragma unroll
        for (int ai = 0; ai < 2; ++ai) { float ssv[4];
#pragma unroll
            for (int m = 0; m < 4; ++m) { const int rl = rl0 + ai * HALF + m * 16; const int row = u.pm * BM + rl; const float s = mode ? rs[rl] : scale; float ss = 0.f;
#pragma unroll
                for (int bj = 0; bj < 2; ++bj) { const size_t off = (size_t)row * LD + col0 + bj * HALF;
                    f32x4 a0 = acc[ai][bj][m][0] * s, a1 = acc[ai][bj][m][1] * s;
                    if (mode) { const u32x4 pw = *(const u32x4*)(PP + off);
                        const f32x4 p0 = {__uint_as_float(pw.x << 16), __uint_as_float(pw.x & 0xffff0000u), __uint_as_float(pw.y << 16), __uint_as_float(pw.y & 0xffff0000u)};
                        const f32x4 p1 = {__uint_as_float(pw.z << 16), __uint_as_float(pw.z & 0xffff0000u), __uint_as_float(pw.w << 16), __uint_as_float(pw.w & 0xffff0000u)};
                        a0 = sig4(a0 + bv[bj][0]) * p0; a1 = sig4(a1 + bv[bj][1]) * p1; }
                    const u32x4 hw = hh[ai][m][bj]; f32x4 o0, o1;
                    if (rd16) { const f32x2c q0 = unpk_f16(hw.x), q1 = unpk_f16(hw.y), q2 = unpk_f16(hw.z), q3 = unpk_f16(hw.w); o0 = (f32x4){q0.x, q0.y, q1.x, q1.y}; o1 = (f32x4){q2.x, q2.y, q3.x, q3.y}; }
                    else { o0 = (f32x4){__uint_as_float(hw.x << 16), __uint_as_float(hw.x & 0xffff0000u), __uint_as_float(hw.y << 16), __uint_as_float(hw.y & 0xffff0000u)};
                           o1 = (f32x4){__uint_as_float(hw.z << 16), __uint_as_float(hw.z & 0xffff0000u), __uint_as_float(hw.w << 16), __uint_as_float(hw.w & 0xffff0000u)}; }
                    const f32x4 n0 = o0 + a0, n1 = o1 + a1;
                    if (wr16) { u32x4 wh; wh.x = cvt_pk_f16(n0[0], n0[1]); wh.y = cvt_pk_f16(n0[2], n0[3]); wh.z = cvt_pk_f16(n1[0], n1[1]); wh.w = cvt_pk_f16(n1[2], n1[3]);
                        *(u32x4*)(H16 + off) = wh; }
                    u32x4 w; w.x = cvt_pk_bf16(n0[0], n0[1]); w.y = cvt_pk_bf16(n0[2], n0[3]); w.z = cvt_pk_bf16(n1[0], n1[1]); w.w = cvt_pk_bf16(n1[2], n1[3]);
                    *(u32x4*)(HB + off) = w;
                    ss += (n0[0] * n0[0] + n0[1] * n0[1]) + (n0[2] * n0[2] + n0[3] * n0[3]) + (n1[0] * n1[0] + n1[1] * n1[1]) + (n1[2] * n1[2] + n1[3] * n1[3]); }
                ss += shx(ss, 16, fr + 16 * fq); ss += shx(ss, 32, fr + 16 * fq); ssv[m] = ss; }
            { const float v = fq == 0 ? ssv[0] : fq == 1 ? ssv[1] : fq == 2 ? ssv[2] : ssv[3];
              SSQ[((size_t)u.pn * SSQ_ROWS + (size_t)(u.pm * BM + wr * 64 + ai * HALF + fr + 16 * fq)) * 4 + wc] = v; } }
    }
};

template <class Epi, class Sched, bool ALIGN_EPI = false, bool SP2 = false>
__device__ __forceinline__ void gemm_phase(PG8_LAS unsigned char* lds, const Gemm g, const Sched& S, const Epi& E, int tid_in) {
    int tid_o = tid_in; asm volatile("" : "+v"(tid_o));
    const int tid = tid_o, wid = __builtin_amdgcn_readfirstlane(tid >> 6), lane = tid & 63, wr = wid >> 2, wc = wid & 3, fr = lane & 15, fq = lane >> 4;
    const int K = g.K, nt = K / BK;
    unsigned voffA[2], voffB[2];
#pragma unroll
    for (int i = 0; i < 2; ++i) { int R, C; stage_rc(tid * 16 + i * 8192, R, C); const int Rb = Epi::PERM ? ((R & ~31) + perm32(R & 31)) : R;
        voffA[i] = (unsigned)(R * g.lda + C) * 2u; voffB[i] = (unsigned)(Rb * K + C) * 2u; }
    const size_t kstep = (size_t)(BK * 2);
    const size_t hstep = (size_t)HALF * K * 2, hstepA = (size_t)HALF * g.lda * 2;
    const size_t tstep = 2 * hstep, tstepA = 2 * hstepA;
    const unsigned ldsw = (unsigned)wid * 1024u;
    const int aoff = lds_byte(wr * 64 + fr, fq * 8), boff = lds_byte(wc * 32 + fr, fq * 8);
#define PG8_SA(b, h) (((b) * 2 + (h)) * HTB)
#define PG8_SB(b, h) ((4 + (b) * 2 + (h)) * HTB)
#define PG8_STAGE(bufoff, gbase, voff) do { _Pragma("unroll") for (int _i = 0; _i < 2; ++_i) \
        __builtin_amdgcn_global_load_lds((const unsigned*)((const char*)(gbase) + (voff)[_i]), (PG8_LAS unsigned*)(lds + (bufoff) + ldsw + _i * 8192), 16, 0, 0); } while (0)
#define PG8_LDA(dst, b, h) do { _Pragma("unroll") for (int m = 0; m < 4; ++m) _Pragma("unroll") for (int k = 0; k < 2; ++k) dst[m][k] = *(const PG8_LAS bf16x8*)(lds + PG8_SA(b, h) + aoff + m * 2048 + k * 1024); } while (0)
#define PG8_LDB(dst, b, h) do { _Pragma("unroll") for (int n = 0; n < 2; ++n) _Pragma("unroll") for (int k = 0; k < 2; ++k) dst[n][k] = *(const PG8_LAS bf16x8*)(lds + PG8_SB(b, h) + boff + n * 2048 + k * 1024); } while (0)
#define PG8_MMA(ai, bj, At, Bt) do { __builtin_amdgcn_s_setprio(1); _Pragma("unroll") for (int m = 0; m < 4; ++m) _Pragma("unroll") for (int n = 0; n < 2; ++n) _Pragma("unroll") for (int k = 0; k < 2; ++k) \
        acc[ai][bj][m][n] = __builtin_amdgcn_mfma_f32_16x16x32_bf16(Bt[n][k], At[m][k], acc[ai][bj][m][n], 0, 0, 0); __builtin_amdgcn_s_setprio(0); } while (0)
#define PG8_WAIT_V(n) asm volatile("s_waitcnt vmcnt(" #n ")" ::: "memory")
#define PG8_WAIT_L(n) asm volatile("s_waitcnt lgkmcnt(" #n ")" ::: "memory")
#define PG8_BAR __builtin_amdgcn_s_barrier()
#define PG8_SCHED __builtin_amdgcn_sched_barrier(0)
    Unit cur, nxt; int ui = 0;
    if (!S.next(0, cur)) return;
    f32x4 acc[2][2][4][2];
#pragma unroll
    for (int a = 0; a < 2; ++a)
#pragma unroll
        for (int b = 0; b < 2; ++b)
#pragma unroll
            for (int m = 0; m < 4; ++m)
#pragma unroll
                for (int n = 0; n < 2; ++n) acc[a][b][m][n] = (f32x4){0.f, 0.f, 0.f, 0.f};
    bf16x8 At[4][2], B0[2][2], B1[2][2];
    const char* cA = (const char*)g.A + (size_t)cur.pm * tstepA; const char* cB = (const char*)g.Bt + (size_t)cur.pn * tstep;
    S.a_ready(cur);
    if constexpr (SP2) {
        PG8_STAGE(PG8_SB(0, 0), cB, voffB); PG8_STAGE(PG8_SB(0, 1), cB + hstep, voffB); PG8_STAGE(PG8_SA(0, 0), cA, voffA); PG8_STAGE(PG8_SA(0, 1), cA + hstepA, voffA);
        PG8_STAGE(PG8_SB(1, 0), cB + kstep, voffB); PG8_STAGE(PG8_SA(1, 0), cA + kstep, voffA); PG8_STAGE(PG8_SB(1, 1), cB + hstep + kstep, voffB);
        PG8_SCHED; E.pre(tid); PG8_SCHED;
        if (wr == 1) PG8_BAR;
        PG8_WAIT_V(8); PG8_BAR;
        PG8_WAIT_V(6); PG8_BAR;
    } else {
        PG8_STAGE(PG8_SB(0, 0), cB, voffB); PG8_STAGE(PG8_SA(0, 0), cA, voffA); PG8_STAGE(PG8_SB(0, 1), cB + hstep, voffB); PG8_STAGE(PG8_SA(0, 1), cA + hstepA, voffA);
        if (wr == 1) PG8_BAR;
        PG8_WAIT_V(4); PG8_BAR;
        PG8_STAGE(PG8_SB(1, 0), cB + kstep, voffB); PG8_STAGE(PG8_SA(1, 0), cA + kstep, voffA); PG8_STAGE(PG8_SB(1, 1), cB + hstep + kstep, voffB);
        PG8_WAIT_V(6); PG8_BAR;
    }
    for (;;) {
        const bool has_next = S.next(ui + 1, nxt);
        const char* nA = has_next ? (const char*)g.A + (size_t)nxt.pm * tstepA : cA; const char* nB = has_next ? (const char*)g.Bt + (size_t)nxt.pn * tstep : cB;
        for (int t = 0; t < nt; t += 2) {
            const bool last = (t == nt - 2);
            const char* a1 = cA + (size_t)(t + 1) * kstep;
            const char* a2 = last ? nA : cA + (size_t)(t + 2) * kstep; const char* b2 = last ? nB : cB + (size_t)(t + 2) * kstep;
            const char* a3 = a2 + kstep; const char* b3 = b2 + kstep;
            if (last && has_next) S.a_ready(nxt);
            if constexpr (SP2) {
            PG8_LDB(B0, 0, 0); PG8_LDB(B1, 0, 1); PG8_SCHED; PG8_LDA(At, 0, 0); PG8_STAGE(PG8_SA(1, 1), a1 + hstepA, voffA);
            PG8_WAIT_V(8); PG8_WAIT_L(0); PG8_BAR; PG8_MMA(0, 0, At, B0); PG8_MMA(0, 1, At, B1); PG8_BAR; PG8_SCHED;
            PG8_LDA(At, 0, 1); PG8_STAGE(PG8_SB(0, 0), b2, voffB); PG8_STAGE(PG8_SB(0, 1), b2 + hstep, voffB); PG8_STAGE(PG8_SA(0, 0), a2, voffA);
            PG8_WAIT_V(8); PG8_WAIT_L(0); PG8_BAR; PG8_MMA(1, 0, At, B0); PG8_MMA(1, 1, At, B1); PG8_BAR; PG8_SCHED;
            PG8_LDB(B0, 1, 0); PG8_LDB(B1, 1, 1); PG8_SCHED; PG8_LDA(At, 1, 0); PG8_STAGE(PG8_SA(0, 1), a2 + hstepA, voffA);
            PG8_WAIT_V(8); PG8_WAIT_L(0); PG8_BAR; PG8_MMA(0, 0, At, B0); PG8_MMA(0, 1, At, B1); PG8_BAR; PG8_SCHED;
            PG8_LDA(At, 1, 1); PG8_STAGE(PG8_SB(1, 0), b3, voffB); PG8_STAGE(PG8_SB(1, 1), b3 + hstep, voffB); PG8_STAGE(PG8_SA(1, 0), a3, voffA);
            PG8_WAIT_V(8); PG8_WAIT_L(0); PG8_BAR; PG8_MMA(1, 0, At, B0); PG8_MMA(1, 1, At, B1); PG8_BAR; PG8_SCHED;
            } else {
            PG8_LDB(B0, 0, 0); PG8_SCHED; PG8_LDA(At, 0, 0); PG8_STAGE(PG8_SA(1, 1), a1 + hstepA, voffA);
            PG8_WAIT_L(8); PG8_BAR; PG8_WAIT_L(0); PG8_MMA(0, 0, At, B0); PG8_BAR; PG8_SCHED;
            PG8_LDB(B1, 0, 1); PG8_STAGE(PG8_SB(0, 0), b2, voffB);
            PG8_BAR; PG8_WAIT_L(0); PG8_MMA(0, 1, At, B1); PG8_BAR;
            PG8_LDA(At, 0, 1); PG8_STAGE(PG8_SA(0, 0), a2, voffA);
            PG8_BAR; PG8_WAIT_L(0); PG8_MMA(1, 0, At, B0); PG8_BAR; PG8_SCHED;
            PG8_STAGE(PG8_SB(0, 1), b2 + hstep, voffB);
            PG8_WAIT_V(6); PG8_BAR; PG8_MMA(1, 1, At, B1); PG8_BAR;
            PG8_LDB(B0, 1, 0); PG8_SCHED; PG8_LDA(At, 1, 0); PG8_STAGE(PG8_SA(0, 1), a2 + hstepA, voffA);
            PG8_WAIT_L(8); PG8_BAR; PG8_WAIT_L(0); PG8_MMA(0, 0, At, B0); PG8_BAR; PG8_SCHED;
            PG8_LDB(B1, 1, 1); PG8_STAGE(PG8_SB(1, 0), b3, voffB);
            PG8_BAR; PG8_WAIT_L(0); PG8_MMA(0, 1, At, B1); PG8_BAR;
            PG8_LDA(At, 1, 1); PG8_STAGE(PG8_SA(1, 0), a3, voffA);
            PG8_BAR; PG8_WAIT_L(0); PG8_MMA(1, 0, At, B0); PG8_BAR; PG8_SCHED;
            PG8_STAGE(PG8_SB(1, 1), b3 + hstep, voffB);
            PG8_WAIT_V(6); PG8_BAR; PG8_MMA(1, 1, At, B1); PG8_BAR;
            }
        }
        if constexpr (ALIGN_EPI) { if (wr == 0) PG8_BAR; }
        if constexpr (!Epi::AFTER_DRAIN) { E(acc, cur, wr, wc, fr, fq); S.done(cur); }
        if (!has_next) break;
#pragma unroll
        for (int a = 0; a < 2; ++a)
#pragma unroll
            for (int b = 0; b < 2; ++b)
#pragma unroll
                for (int m = 0; m < 4; ++m)
#pragma unroll
                    for (int n = 0; n < 2; ++n) acc[a][b][m][n] = (f32x4){0.f, 0.f, 0.f, 0.f};
        cur = nxt; cA = nA; cB = nB; ++ui;
        if constexpr (ALIGN_EPI) { if (wr == 1) PG8_BAR; }
    }
    PG8_WAIT_V(0);
    if constexpr (!ALIGN_EPI) { if (wr == 0) PG8_BAR; }
    PG8_BAR;
    if constexpr (Epi::AFTER_DRAIN) { E.fused(acc, cur, wr, wc, fr, fq, lds, wid, lane); S.done(cur); }
#undef PG8_SA
#undef PG8_SB
#undef PG8_STAGE
#undef PG8_LDA
#undef PG8_LDB
#undef PG8_MMA
#undef PG8_WAIT_V
#undef PG8_WAIT_L
#undef PG8_BAR
#undef PG8_SCHED
}
}
namespace swa {
using bf16 = __hip_bfloat16;
typedef short bf16x8 __attribute__((ext_vector_type(8)));
typedef short s16x4 __attribute__((ext_vector_type(4)));
typedef float f32x16 __attribute__((ext_vector_type(16)));
typedef float f32x4 __attribute__((ext_vector_type(4)));
typedef unsigned u32x4 __attribute__((ext_vector_type(4)));
constexpr int D = 128;
constexpr float SCALE = 0.08838834764831845f;
constexpr float THR = 8.f;
constexpr int NW = 8, QBLK = 32, KVBLK = 64, QB = NW * QBLK;
constexpr int SHM_V = KVBLK * D * 2, SHM_K = KVBLK * D * 2;
constexpr int NS = 4, LDS_BYTES = NS * (SHM_V + SHM_K);

#define KSWZ(row, colB) ((row) * 256 + ((colB) ^ (((row) & 7) << 4)))
#define SBAR() __builtin_amdgcn_sched_barrier(0)
__device__ __forceinline__ int v_st(int k, int c) { const int kk = (k & ~0xC) | ((k & 4) << 1) | ((k & 8) >> 1); return ((kk >> 3) * 4 + (c >> 5)) * 512 + ((kk & 7) * 32 + (c & 31)) * 2; }
__device__ __forceinline__ int v_rd_base(int lane) { return ((lane & 3) << 3) | (((lane >> 2) & 3) << 6) | (((lane >> 4) & 1) << 5) | (((lane >> 5) & 1) << 8); }
constexpr int v_rd_off(int d0, int ks, int half) { return d0 * 512 + ks * 4096 + half * 2048; }
__device__ __forceinline__ int crow(int r, int hi) { return (r & 3) + 8 * (r >> 2) + 4 * hi; }
__device__ __forceinline__ unsigned cvtpk(float lo, float hi) { unsigned r; asm volatile("v_cvt_pk_bf16_f32 %0, %1, %2" : "=v"(r) : "v"(lo), "v"(hi)); return r; }
__device__ __forceinline__ bf16x8 load8(const bf16* p) { return *reinterpret_cast<const bf16x8*>(p); }
__device__ __forceinline__ void mask_tile(f32x16& p0, f32x16& p1, int dq, unsigned W) {
    const float NEG = -__builtin_inff();
#pragma unroll
    for (int r = 0; r < 16; ++r) {
        const int c = (r & 3) + 8 * (r >> 2);
        if ((unsigned)(dq - c) >= W) p0[r] = NEG;
        if ((unsigned)(dq - c - 32) >= W) p1[r] = NEG;
    }
}
__device__ __forceinline__ void partialSM(f32x16& p0, f32x16& p1, float& m_reg, float& mn, float& alpha) {
    float pmax = p0[0]; for (int r = 1; r < 16; ++r) pmax = fmaxf(pmax, p0[r]); for (int r = 0; r < 16; ++r) pmax = fmaxf(pmax, p1[r]);
    { auto rr = __builtin_amdgcn_permlane32_swap(__float_as_uint(pmax), __float_as_uint(pmax), false, false);
      pmax = fmaxf(__uint_as_float(rr[0]), __uint_as_float(rr[1])); }
    constexpr float C2 = 1.4426950408889634f * SCALE;
    if (__builtin_expect(__all((pmax - m_reg) * SCALE <= THR), 1)) { mn = m_reg; alpha = 1.f; }
    else { mn = fmaxf(m_reg, pmax); alpha = __builtin_amdgcn_exp2f((m_reg - mn) * C2); m_reg = mn; }
    const float mnL = -mn * C2;
    for (int r = 0; r < 16; ++r) p0[r] = fmaf(p0[r], C2, mnL); for (int r = 0; r < 16; ++r) p1[r] = fmaf(p1[r], C2, mnL);
    for (int r = 0; r < 16; ++r) p0[r] = __builtin_amdgcn_exp2f(p0[r]);
}
__device__ __forceinline__ void finishSM(f32x16& p0, f32x16& p1, float alpha, float& l_reg, bf16x8& pa0, bf16x8& pa1, bf16x8& pa2, bf16x8& pa3) {
    for (int r = 0; r < 16; ++r) p1[r] = __builtin_amdgcn_exp2f(p1[r]);
    float ps = 0; for (int r = 0; r < 16; ++r) ps += p0[r]; for (int r = 0; r < 16; ++r) ps += p1[r];
    { auto rr = __builtin_amdgcn_permlane32_swap(__float_as_uint(ps), __float_as_uint(ps), false, false);
      ps = __uint_as_float(rr[0]) + __uint_as_float(rr[1]); }
    l_reg = l_reg * alpha + ps;
#define PK4(P, B_, OUT) do { unsigned a0 = cvtpk(P[B_+0], P[B_+1]), a1 = cvtpk(P[B_+2], P[B_+3]);                          \
        unsigned b0 = cvtpk(P[B_+4], P[B_+5]), b1 = cvtpk(P[B_+6], P[B_+7]);                                             \
        auto r0 = __builtin_amdgcn_permlane32_swap(a0, b0, false, false); auto r1 = __builtin_amdgcn_permlane32_swap(a1, b1, false, false); \
        u32x4 w = {r0[0], r1[0], r0[1], r1[1]}; OUT = *reinterpret_cast<bf16x8*>(&w); } while (0)
    PK4(p0, 0, pa0); PK4(p0, 8, pa1); PK4(p1, 0, pa2); PK4(p1, 8, pa3);
#undef PK4
}
template <int KB, bool SK>
__device__ __forceinline__ void qkt(f32x16& p0, f32x16& p1, const char* K_lds, int r32, int hi, const bf16x8* qr, bool act) {
    if (SK && !act) { const float NEG = -__builtin_inff();
#pragma unroll
        for (int r = 0; r < 16; ++r) { p0[r] = NEG; p1[r] = NEG; } return; }
    p0 = f32x16{}; p1 = f32x16{};
    const char* kb[4];
#pragma unroll
    for (int dd = 0; dd < 4; ++dd) kb[dd] = K_lds + KB * SHM_K + KSWZ(r32, (dd * 16 + hi * 8) * 2);
#pragma unroll
    for (int d0 = 0; d0 < 8; ++d0) { const char* a = kb[d0 & 3] + (d0 >> 2) * 128;
        bf16x8 b0 = *reinterpret_cast<const bf16x8*>(a);
        bf16x8 b1 = *reinterpret_cast<const bf16x8*>(a + 32 * 256);
        p0 = __builtin_amdgcn_mfma_f32_32x32x16_bf16(b0, qr[d0], p0, 0, 0, 0);
        p1 = __builtin_amdgcn_mfma_f32_32x32x16_bf16(b1, qr[d0], p1, 0, 0, 0); }
}
template <int VB, bool SK>
__device__ __forceinline__ void pv_tile(f32x16* o, int vb0, bf16x8 pa0, bf16x8 pa1, bf16x8 pa2, bf16x8 pa3, bool act) {
    if (SK && !act) return;
#define TRRD(dst, off) asm volatile("ds_read_b64_tr_b16 %0, %1 offset:%2" : "=&v"(dst) : "v"(vb0), "i"(off) : "memory")
#define PV_D0(d0) do { s16x4 l0, l1, l2, l3, h0, h1, h2, h3; constexpr int b_ = VB * SHM_V + v_rd_off(d0, 0, 0); \
        TRRD(l0, b_); TRRD(h0, b_ + 2048); TRRD(l1, b_ + 4096); TRRD(h1, b_ + 6144); TRRD(l2, b_ + 8192); TRRD(h2, b_ + 10240); TRRD(l3, b_ + 12288); TRRD(h3, b_ + 14336); \
        asm volatile("s_waitcnt lgkmcnt(0)" ::: "memory"); SBAR();   \
        o[d0] = __builtin_amdgcn_mfma_f32_32x32x16_bf16((bf16x8){l0[0], l0[1], l0[2], l0[3], h0[0], h0[1], h0[2], h0[3]}, pa0, o[d0], 0, 0, 0);   \
        o[d0] = __builtin_amdgcn_mfma_f32_32x32x16_bf16((bf16x8){l1[0], l1[1], l1[2], l1[3], h1[0], h1[1], h1[2], h1[3]}, pa1, o[d0], 0, 0, 0);   \
        o[d0] = __builtin_amdgcn_mfma_f32_32x32x16_bf16((bf16x8){l2[0], l2[1], l2[2], l2[3], h2[0], h2[1], h2[2], h2[3]}, pa2, o[d0], 0, 0, 0);   \
        o[d0] = __builtin_amdgcn_mfma_f32_32x32x16_bf16((bf16x8){l3[0], l3[1], l3[2], l3[3], h3[0], h3[1], h3[2], h3[3]}, pa3, o[d0], 0, 0, 0); } while (0)
    PV_D0(0); PV_D0(1); PV_D0(2); PV_D0(3);
#undef PV_D0
#undef TRRD
}

struct BlockRef { const bf16* Q; const bf16* K; const bf16* V; bf16* O; float* L; int P0, skv, qs, kvs, os, ls, span, wpb, qsub, osub, lsub; };
struct Seam { bf16x8 qr[8]; int g; };
__device__ __forceinline__ int swa_jlo(int P0, int W) { const int lowk = P0 - W + 1; return lowk > 0 ? lowk / KVBLK : 0; }
#define VMW() asm volatile("s_waitcnt vmcnt(0)" ::: "memory")
#define VMWN(n) asm volatile("s_waitcnt vmcnt(%0)" :: "i"(n) : "memory")
#define LGW() asm volatile("s_waitcnt lgkmcnt(0)" ::: "memory")
typedef __attribute__((address_space(3))) unsigned char lds_u8;
struct DmaLane { unsigned kr0, kc0, kr1, kc1, vr0, vc0, vr1, vc1; };
__device__ __forceinline__ DmaLane dma_lane(int wid, int lane) {
    DmaLane d; const unsigned L = (unsigned)lane;
    d.kr0 = 8u * wid + (L >> 4); d.kr1 = d.kr0 + 4u; d.kc0 = ((L & 15u) ^ (d.kr0 & 7u)) * 16u; d.kc1 = ((L & 15u) ^ (d.kr1 & 7u)) * 16u;
    const unsigned s0 = 4u * wid + (L >> 5), s1 = s0 + 2u;
    const unsigned k0 = ((s0 >> 2) << 3) | ((L >> 2) & 7u), k1 = ((s1 >> 2) << 3) | ((L >> 2) & 7u);
    d.vr0 = (k0 & ~0xCu) | ((k0 & 4u) << 1) | ((k0 & 8u) >> 1); d.vr1 = (k1 & ~0xCu) | ((k1 & 4u) << 1) | ((k1 & 8u) >> 1);
    d.vc0 = ((s0 & 3u) * 32u + (L & 3u) * 8u) * 2u; d.vc1 = ((s1 & 3u) * 32u + (L & 3u) * 8u) * 2u;
    return d;
}
#define DMA16(gp, lp) __builtin_amdgcn_global_load_lds((const unsigned*)(gp), (__attribute__((address_space(3))) unsigned*)(lp), 16, 0, 0)
#define TILE_DMA(Kp, Vp, k0, st, slot) do { const unsigned st2_ = (unsigned)(st) * 2u, t0_ = (unsigned)(k0) * st2_;                                         \
        const char* kg_ = (const char*)(Kp) + t0_; const char* vg_ = (const char*)(Vp) + t0_;                                                                            \
        lds_u8* kl_ = ldsl + 4 * SHM_V + (slot) * SHM_K + wid * 2048; lds_u8* vl_ = ldsl + (slot) * SHM_V + wid * 2048;                                                 \
        DMA16(kg_ + (dl.kr0 * st2_ + dl.kc0), kl_); DMA16(kg_ + (dl.kr1 * st2_ + dl.kc1), kl_ + 1024);                                                                   \
        DMA16(vg_ + (dl.vr0 * st2_ + dl.vc0), vl_); DMA16(vg_ + (dl.vr1 * st2_ + dl.vc1), vl_ + 1024); } while (0)
#define QLOAD(R_) do { const int sub_ = wid / (R_).wpb, wq_ = wid - sub_ * (R_).wpb; const unsigned qo_ = (unsigned)(sub_ * (R_).qsub + (wq_ * QBLK + r32) * (R_).qs + hi * 8) * 2u;   \
        _Pragma("unroll") for (int d0 = 0; d0 < 8; ++d0) S.qr[d0] = *(const bf16x8*)((const char*)(R_).Q + qo_ + d0 * 32); } while (0)
__device__ __forceinline__ int swa_nt(const BlockRef& R, int W, int& j_lo) { j_lo = swa_jlo(R.P0, W); int j_hi = (R.P0 + R.span - 1) / KVBLK + 1; if (j_hi > R.skv / KVBLK) j_hi = R.skv / KVBLK;
    if (j_hi < j_lo + 2) j_hi = j_lo + 2; return j_hi - j_lo; }
__device__ __forceinline__ void causal_swa_prime(const BlockRef& cur, int W, char* lds, lds_u8* ldsl, Seam& S, int wave_s  ) {
    int tid_o = wave_s * 64 + lane_id_v(); asm volatile("" : "+v"(tid_o));
    const int tid = tid_o, wid = __builtin_amdgcn_readfirstlane(tid >> 6), lane = tid & 63, r32 = lane & 31, hi = lane >> 5;
    const DmaLane dl = dma_lane(wid, lane);
    const int kb0 = swa_jlo(cur.P0, W) * KVBLK;
    TILE_DMA(cur.K, cur.V, kb0, cur.kvs, 0); TILE_DMA(cur.K, cur.V, kb0 + KVBLK, cur.kvs, 1);
    QLOAD(cur); S.g = 0;
    VMW(); __builtin_amdgcn_s_barrier();
}
template <bool SK>
__device__ __forceinline__ void causal_swa_block(const BlockRef& cur, const BlockRef& nxt, int W, char* lds, lds_u8* ldsl, Seam& S, int wave_s  ) {
    int tid_o = wave_s * 64 + lane_id_v(); asm volatile("" : "+v"(tid_o));
    const int tid = tid_o, wid = __builtin_amdgcn_readfirstlane(tid >> 6), lane = tid & 63, r32 = lane & 31, hi = lane >> 5;
    int j_lo, jn_lo; const int NT = swa_nt(cur, W, j_lo); (void)swa_nt(nxt, W, jn_lo);
    const int sub = wid / cur.wpb, wq = wid - sub * cur.wpb;
    const int qlo = cur.P0 + wq * QBLK, qm = qlo + r32 - 4 * hi;
    char* V_lds = lds; char* K_lds = lds + 4 * SHM_V;
    float m_reg = -1e30f, l_reg = 0; f32x16 o[4] = {};
    const int vb0 = (int)(uintptr_t)V_lds + v_rd_base(lane);
    const int g = __builtin_amdgcn_readfirstlane(S.g);
#define RESC(a) do { if (__any((a) < 1.f)) { for (int d_ = 0; d_ < 4; ++d_) for (int r = 0; r < 16; ++r) o[d_][r] *= (a); } } while (0)
#define KBASE(t) ((j_lo + (t)) * KVBLK)
#define ACT(t) (KBASE(t) <= qlo + QBLK - 1 && KBASE(t) + KVBLK - 1 >= qlo - W + 1)
#define MASKT(P0_, P1_, t) do { const int kb_ = KBASE(t); if ((!SK || ACT(t)) && (kb_ + KVBLK - 1 > qlo || kb_ <= qlo + QBLK - 1 - W)) mask_tile(P0_, P1_, qm - kb_, (unsigned)W); } while (0)
#define SLOT(t) ((g + (t)) & 3)
#define ISSUE(f) do { const int f_ = (f); int l_ = lane; asm volatile("" : "+v"(l_)); const DmaLane dl = dma_lane(wid, l_);     \
        const bool own_ = f_ < NT; const bf16* Kp_ = own_ ? cur.K : nxt.K; const bf16* Vp_ = own_ ? cur.V : nxt.V; const int st_ = own_ ? cur.kvs : nxt.kvs;                  \
        const int k0_ = own_ ? KBASE(f_) : (jn_lo + f_ - NT) * KVBLK; TILE_DMA(Kp_, Vp_, k0_, st_, SLOT(f_)); } while (0)
#define STEP_END() do { VMWN(4); LGW(); __builtin_amdgcn_s_barrier(); SBAR(); } while (0)
    f32x16 pA0, pA1, pB0, pB1; float mnA, mnB, alA, alB; bf16x8 pa0, pa1, pa2, pa3;
    ISSUE(2); SBAR();
    qkt<0, SK>(pA0, pA1, K_lds + SLOT(0) * SHM_K, r32, hi, S.qr, ACT(0));
    MASKT(pA0, pA1, 0); partialSM(pA0, pA1, m_reg, mnA, alA);
    STEP_END();
#define STEP(PX0, PX1, mnX, alX, PY0, PY1, alY, t) do {                                                                      \
        ISSUE((t) + 2); SBAR(); qkt<0, SK>(PX0, PX1, K_lds + SLOT(t) * SHM_K, r32, hi, S.qr, ACT(t));                        \
        finishSM(PY0, PY1, alY, l_reg, pa0, pa1, pa2, pa3); SBAR();                                                           \
        pv_tile<0, SK>(o, vb0 + SLOT((t) - 1) * SHM_V, pa0, pa1, pa2, pa3, ACT((t) - 1)); MASKT(PX0, PX1, (t)); partialSM(PX0, PX1, m_reg, mnX, alX);   \
        RESC(alX); STEP_END(); } while (0)
    for (int t = 1; t + 1 < NT; t += 2) {
        STEP(pB0, pB1, mnB, alB, pA0, pA1, alA, t);
        STEP(pA0, pA1, mnA, alA, pB0, pB1, alB, t + 1);
    }
    const bool even = (NT & 1) == 0;
    if (even) STEP(pB0, pB1, mnB, alB, pA0, pA1, alA, NT - 1);
    QLOAD(nxt); SBAR();
    if (even) { finishSM(pB0, pB1, alB, l_reg, pa0, pa1, pa2, pa3); SBAR(); pv_tile<0, SK>(o, vb0 + SLOT(NT - 1) * SHM_V, pa0, pa1, pa2, pa3, ACT(NT - 1)); }
    else      { finishSM(pA0, pA1, alA, l_reg, pa0, pa1, pa2, pa3); SBAR(); pv_tile<0, SK>(o, vb0 + SLOT(NT - 1) * SHM_V, pa0, pa1, pa2, pa3, ACT(NT - 1)); }
    SBAR();
    { const float rl_ = __builtin_amdgcn_rcpf(l_reg);
      char* Ow = (char*)cur.O + ((size_t)sub * cur.osub + (size_t)(wq * QBLK) * cur.os) * 2; const unsigned oo_ = (unsigned)(r32 * cur.os + 8 * hi) * 2u;
#define PKO(P, B_, OUT) do { unsigned a0 = cvtpk(P[B_+0] * rl_, P[B_+1] * rl_), a1 = cvtpk(P[B_+2] * rl_, P[B_+3] * rl_);                          \
        unsigned b0 = cvtpk(P[B_+4] * rl_, P[B_+5] * rl_), b1 = cvtpk(P[B_+6] * rl_, P[B_+7] * rl_);                                             \
        auto r0 = __builtin_amdgcn_permlane32_swap(a0, b0, false, false); auto r1 = __builtin_amdgcn_permlane32_swap(a1, b1, false, false); \
        OUT = (u32x4){r0[0], r1[0], r0[1], r1[1]}; } while (0)
#pragma unroll
      for (int d0 = 0; d0 < 4; ++d0) { u32x4 w01, w23; PKO(o[d0], 0, w01); PKO(o[d0], 8, w23);
          *(u32x4*)(Ow + oo_ + d0 * 64) = w01; *(u32x4*)(Ow + oo_ + d0 * 64 + 32) = w23; }
#undef PKO
    }
    if (cur.L != nullptr && hi == 0) cur.L[(size_t)sub * cur.lsub + (size_t)(wq * QBLK + r32) * cur.ls] = m_reg * (1.4426950408889634f * SCALE) + __builtin_amdgcn_logf(l_reg);
    S.g = (g + NT) & 3;
#undef RESC
#undef KBASE
#undef ACT
#undef MASKT
#undef SLOT
#undef ISSUE
#undef STEP_END
#undef STEP
}
struct DRef { const bf16* Q; const bf16* K; const bf16* V; bf16* O; int P0; };
struct DSeam { bf16x8 qr[8]; int g; };
constexpr int D_K = 0, D_V = 2 * SHM_K, D_P = D_V + 4 * SHM_V, D_AL = D_P + 2 * 16384, D_LDS_BYTES = D_AL + 2 * 1024;
#define DU_K(Kp, k0, slot) do { int l_ = lane; asm volatile("" : "+v"(l_)); const unsigned L_ = (unsigned)l_; const char* kg_ = (const char*)(Kp) + (unsigned)(k0) * st2; lds_u8* kl_ = ldsl + D_K + (slot) * SHM_K + u4 * 4096;   \
        _Pragma("unroll") for (int i_ = 0; i_ < 4; ++i_) { const unsigned kr_ = 16u * u4 + 4u * i_ + (L_ >> 4); DMA16(kg_ + (kr_ * st2 + ((L_ & 15u) ^ (kr_ & 7u)) * 16u), kl_ + i_ * 1024); } } while (0)
#define DU_V(Vp, k0, slot) do { int l_ = lane; asm volatile("" : "+v"(l_)); const unsigned L_ = (unsigned)l_; const char* vg_ = (const char*)(Vp) + (unsigned)(k0) * st2 + (u4 >> 1) * 256;                                   \
        lds_u8* vl_ = ldsl + D_V + ((u4 >> 1) * 2 + (slot)) * SHM_V + (u4 & 1) * 1024;                                                                                                                     \
        _Pragma("unroll") for (int i_ = 0; i_ < 8; ++i_) { const unsigned s_ = 4u * i_ + 2u * (u4 & 1) + (L_ >> 5), kk_ = ((s_ >> 2) << 3) | ((L_ >> 2) & 7u), vr_ = (kk_ & ~0xCu) | ((kk_ & 4u) << 1) | ((kk_ & 8u) >> 1);   \
            DMA16(vg_ + (vr_ * st2 + ((s_ & 3u) * 32u + (L_ & 3u) * 8u) * 2u), vl_ + i_ * 2048); } } while (0)
#define DU_ISSUE_K(f) do { const int f_ = (f); const bool own_ = f_ < NT; DU_K(own_ ? cur.K : nxt.K, own_ ? 64 * f_ : 64 * (f_ - NT), (g + f_) & 1); } while (0)
#define DU_ISSUE_V(f) do { const int f_ = (f); const bool own_ = f_ < NT; DU_V(own_ ? cur.V : nxt.V, own_ ? 64 * f_ : 64 * (f_ - NT), (g + f_) & 1); } while (0)
#define D_QLOAD(R_) do { const unsigned qo_ = (unsigned)((wid * QBLK + r32) * qs + hi * 8) * 2u; _Pragma("unroll") for (int d0 = 0; d0 < 8; ++d0) S.qr[d0] = *(const bf16x8*)((const char*)(R_).Q + qo_ + d0 * 32); } while (0)
#define PKO2(P, B_, OUT) do { unsigned a0 = cvtpk(P[B_+0] * rl_, P[B_+1] * rl_), a1 = cvtpk(P[B_+2] * rl_, P[B_+3] * rl_);                          \
        unsigned b0 = cvtpk(P[B_+4] * rl_, P[B_+5] * rl_), b1 = cvtpk(P[B_+6] * rl_, P[B_+7] * rl_);                                             \
        auto r0 = __builtin_amdgcn_permlane32_swap(a0, b0, false, false); auto r1 = __builtin_amdgcn_permlane32_swap(a1, b1, false, false); \
        OUT = (u32x4){r0[0], r1[0], r0[1], r1[1]}; } while (0)
__device__ __forceinline__ void dattn_prime(const DRef& cur, int qs, int kvs, lds_u8* ldsl, DSeam& S, int wave_s) {
    int tid_o = wave_s * 64 + lane_id_v(); const int tid = tid_o, wid = __builtin_amdgcn_readfirstlane(tid >> 6), lane = tid & 63, r32 = lane & 31, hi = lane >> 5;
    if (wid < 4) { D_QLOAD(cur); }
    else { const unsigned u4 = (unsigned)(wid - 4); const unsigned st2 = (unsigned)kvs * 2u; DU_K(cur.K, 0, 0); DU_V(cur.V, 0, 0); DU_V(cur.V, 64, 1); }
    S.g = 0; VMW(); __builtin_amdgcn_s_barrier();
}
__device__ __forceinline__ void dattn_block_lower(const DRef& cur, const DRef& nxt, int qs, char* lds, DSeam& S, int wave_s) {
    int tid_o = wave_s * 64 + lane_id_v(); const int tid = tid_o, wid = __builtin_amdgcn_readfirstlane(tid >> 6), lane = tid & 63, r32 = lane & 31, hi = lane >> 5;
    const int NT = cur.P0 / KVBLK + 2, wq = wid, qlo = cur.P0 + wq * QBLK, qm = qlo + r32 - 4 * hi, g = __builtin_amdgcn_readfirstlane(S.g);
    char* K_lds = lds + D_K; char* P_w = lds + D_P + wq * 4096 + lane * 16; float* al_w = (float*)(lds + D_AL) + wq * 64;
    float m_reg = -1e30f, l_reg = 0;
    for (int t = 0; t < NT; ++t) {
        f32x16 p0, p1; float mn, al; bf16x8 pa0, pa1, pa2, pa3; const int par = (g + t) & 1;
        qkt<0, false>(p0, p1, K_lds + par * SHM_K, r32, hi, S.qr, true);
        { const int kb_ = t * KVBLK; if (kb_ + KVBLK - 1 > qlo) mask_tile(p0, p1, qm - kb_, 0x7fffffffu); }
        partialSM(p0, p1, m_reg, mn, al); finishSM(p0, p1, al, l_reg, pa0, pa1, pa2, pa3);
        { char* pw_ = P_w + par * 16384; *(bf16x8*)(pw_) = pa0; *(bf16x8*)(pw_ + 1024) = pa1; *(bf16x8*)(pw_ + 2048) = pa2; *(bf16x8*)(pw_ + 3072) = pa3; }
        if (hi == 0) { al_w[par * 256 + r32] = al; al_w[par * 256 + 32 + r32] = l_reg; }
        LGW(); __builtin_amdgcn_s_barrier(); SBAR();
    }
    D_QLOAD(nxt);
    S.g = (g + NT) & 1;
}
__device__ __forceinline__ void dattn_block_upper(const DRef& cur, const DRef& nxt, int kvs, int os, char* lds, lds_u8* ldsl, DSeam& S, int wave_s) {
    int tid_o = wave_s * 64 + lane_id_v(); const int tid = tid_o, wid = __builtin_amdgcn_readfirstlane(tid >> 6), lane = tid & 63, r32 = lane & 31, hi = lane >> 5;
    const int NT = cur.P0 / KVBLK + 2, g = __builtin_amdgcn_readfirstlane(S.g); const unsigned u4 = (unsigned)(wid - 4), st2 = (unsigned)kvs * 2u;
    const int vb = (int)(uintptr_t)(lds + D_V) + (int)(u4 >> 1) * 2 * SHM_V + v_rd_base(lane);
    const char* P_l = lds + D_P + lane * 16; const float* al_l = (const float*)(lds + D_AL);
    f32x16 o[4][2] = {};
#define TRRD(dst, off) asm volatile("ds_read_b64_tr_b16 %0, %1 offset:%2" : "=&v"(dst) : "v"(vbs_), "i"(off) : "memory")
#define D_UP_DG(dg) do { s16x4 l0, l1, l2, l3, h0, h1, h2, h3; constexpr int b_ = 512 * (dg);                                                                                       \
        TRRD(l0, b_); TRRD(h0, b_ + 2048); TRRD(l1, b_ + 4096); TRRD(h1, b_ + 6144); TRRD(l2, b_ + 8192); TRRD(h2, b_ + 10240); TRRD(l3, b_ + 12288); TRRD(h3, b_ + 14336);      \
        asm volatile("s_waitcnt lgkmcnt(0)" ::: "memory"); SBAR();                                                                                                                  \
        _Pragma("unroll") for (int qt = 0; qt < 4; ++qt) {                                                                                                                          \
            o[qt][dg] = __builtin_amdgcn_mfma_f32_32x32x16_bf16((bf16x8){l0[0], l0[1], l0[2], l0[3], h0[0], h0[1], h0[2], h0[3]}, pa[qt][0], o[qt][dg], 0, 0, 0);                   \
            o[qt][dg] = __builtin_amdgcn_mfma_f32_32x32x16_bf16((bf16x8){l1[0], l1[1], l1[2], l1[3], h1[0], h1[1], h1[2], h1[3]}, pa[qt][1], o[qt][dg], 0, 0, 0);                   \
            o[qt][dg] = __builtin_amdgcn_mfma_f32_32x32x16_bf16((bf16x8){l2[0], l2[1], l2[2], l2[3], h2[0], h2[1], h2[2], h2[3]}, pa[qt][2], o[qt][dg], 0, 0, 0);                   \
            o[qt][dg] = __builtin_amdgcn_mfma_f32_32x32x16_bf16((bf16x8){l3[0], l3[1], l3[2], l3[3], h3[0], h3[1], h3[2], h3[3]}, pa[qt][3], o[qt][dg], 0, 0, 0); } } while (0)
#define D_UP_TILE(u) do { const int u_ = (u), par_ = (g + u_) & 1; const char* pr_ = P_l + par_ * 16384; bf16x8 pa[4][4];                                                           \
        _Pragma("unroll") for (int qt = 0; qt < 4; ++qt) { _Pragma("unroll") for (int k = 0; k < 4; ++k) pa[qt][k] = *(const bf16x8*)(pr_ + qt * 4096 + k * 1024);                  \
            const float al = al_l[par_ * 256 + qt * 64 + r32]; if (__any(al < 1.f)) { for (int r = 0; r < 16; ++r) { o[qt][0][r] *= al; o[qt][1][r] *= al; } } }                    \
        const int vbs_ = vb + par_ * SHM_V + (int)(u4 & 1) * 1024; SBAR(); D_UP_DG(0); D_UP_DG(1); SBAR();                                                                          \
        DU_ISSUE_V(u_ + 2); } while (0)
    for (int t = 0; t < NT; ++t) {
        DU_ISSUE_K(t + 1); SBAR();
        if (t > 0) { D_UP_TILE(t - 1); VMWN(8); }
        else VMW();
        LGW(); __builtin_amdgcn_s_barrier(); SBAR();
    }
    D_UP_TILE(NT - 1);
    { const int parl = (g + NT - 1) & 1; char* Ob = (char*)cur.O + (size_t)(64 * u4) * 2; const unsigned oo_ = (unsigned)(r32 * os + 8 * hi) * 2u;
#pragma unroll
      for (int qt = 0; qt < 4; ++qt) { const float rl_ = __builtin_amdgcn_rcpf(al_l[parl * 256 + qt * 64 + 32 + r32]); char* Ow = Ob + (size_t)(qt * QBLK) * os * 2;
#pragma unroll
          for (int dg = 0; dg < 2; ++dg) { u32x4 w01, w23; PKO2(o[qt][dg], 0, w01); PKO2(o[qt][dg], 8, w23);
              *(u32x4*)(Ow + oo_ + dg * 64) = w01; *(u32x4*)(Ow + oo_ + dg * 64 + 32) = w23; } } }
    S.g = (g + NT) & 1;
#undef D_UP_TILE
#undef D_UP_DG
#undef TRRD
}
#undef DU_K
#undef DU_V
#undef DU_ISSUE_K
#undef DU_ISSUE_V
#undef D_QLOAD
#undef PKO2
__device__ __forceinline__ void causal_swa_finish() { __builtin_amdgcn_s_setprio(0); VMW(); __builtin_amdgcn_s_barrier(); }
#undef VMW
#undef VMWN
#undef LGW
#undef DMA16
#undef TILE_DMA
#undef QLOAD
#undef KSWZ
#undef SBAR
}


constexpr int NWAVES = 8;
#ifndef MK_PER_PHASE
#define MK_PER_PHASE 0
#endif

constexpr int BATCH = 2, SEQ = 8192, DM = 2048, FF = 5632, PLE = 256, DEPTH = 4, HD = 128;
constexpr int M = BATCH * SEQ;
constexpr int NA = 5120, NB = 6144, NC = 6144;
constexpr int NQ = 6144;
constexpr float RMS_EPS = 1e-6f, SUBLN_EPS = 1e-5f;
constexpr int N_PHASES = 37;
#ifndef RES16_PAIRS
#define RES16_PAIRS 4
#endif

constexpr size_t MiB = 1u << 20;
constexpr size_t WS_CTL = 0, CTL_ZERO_BYTES = 1 * MiB;
constexpr size_t WS_SSQ0 = 1 * MiB, WS_SSQ1 = 3 * MiB;
constexpr size_t WS_LSE = 5 * MiB;
constexpr size_t WS_H16 = 8 * MiB;
constexpr size_t WS_HB0 = 136 * MiB, WS_HB1 = 200 * MiB;
constexpr size_t WS_BIG = 264 * MiB;
constexpr size_t WS_AO = 456 * MiB;
constexpr size_t WS_OT = 520 * MiB;
constexpr size_t WS_PB = 712 * MiB;
constexpr size_t WS_W = 744 * MiB;
constexpr size_t WL_FFN1_IN = 0, WL_FFN1_OUT = WL_FFN1_IN + (size_t)2 * FF * DM, WL_FFN2_IN = WL_FFN1_OUT + (size_t)DM * FF, WL_FFN2_OUT = WL_FFN2_IN + (size_t)2 * FF * DM,
                 WL_PLE_G = WL_FFN2_OUT + (size_t)DM * FF, WL_PLE_P = WL_PLE_G + (size_t)DM * DM, WL_MIX_IN = WL_PLE_P + (size_t)DM * PLE, WL_MIX_OUT = WL_MIX_IN + (size_t)6144 * DM,
                 WL_SIZE = WL_MIX_OUT + (size_t)DM * DM;
constexpr size_t WS_END = WS_W + (size_t)DEPTH * WL_SIZE * 2;
constexpr int CW_BAR = 4096;

constexpr int RING_OFF = 0, RING_BYTES = 131072;
constexpr int LDSCTL_OFF = 139264, MISC_OFF = LDSCTL_OFF + 320;
constexpr int RSTD_OFF = LDSCTL_OFF + 1024;
constexpr int LDS_BYTES = 147456;
static_assert(MISC_OFF + 128 <= RSTD_OFF && RSTD_OFF + 1024 <= LDS_BYTES, "LDS map");

#define GAS __attribute__((address_space(1)))
#define LAS __attribute__((address_space(3)))
typedef unsigned short bf16;
typedef unsigned v4u __attribute__((ext_vector_type(4)));
typedef float f32x4 __attribute__((ext_vector_type(4)));
typedef short bf16x8 __attribute__((ext_vector_type(8)));
typedef GAS unsigned gu32;
typedef GAS unsigned long long gu64;
#define RLX_AGENT __ATOMIC_RELAXED, __HIP_MEMORY_SCOPE_AGENT
#define LDS_WAIT() asm volatile("s_waitcnt lgkmcnt(0)" ::: "memory")
#define VM_WAIT() asm volatile("s_waitcnt vmcnt(0)" ::: "memory")
__device__ __forceinline__ unsigned long long rt() { return __builtin_amdgcn_s_memrealtime(); }
__device__ __forceinline__ unsigned f2bf(float f) { unsigned u = __builtin_bit_cast(unsigned, f); return (u + 0x7fffu + ((u >> 16) & 1u)) >> 16; }
__device__ __forceinline__ unsigned pk2(float lo, float hi) { return f2bf(lo) | (f2bf(hi) << 16); }

#define XB_TMO      128
#define XB_XCNT(j)  (256  + 64 * (j))
#define XB_XSUB(j)  (1280 + 64 * (j))
#define XB_XGEN(j)  (2304 + 64 * (j))
#define XB_TOP      3328
#define XB_TOPGEN   3392
#define XCD_BAR_WORDS 3456
#define XB_SPIN_CAP (1u << 18)

__device__ __forceinline__ unsigned xb_ld(unsigned* p)              { return __hip_atomic_load(p, __ATOMIC_RELAXED, __HIP_MEMORY_SCOPE_AGENT); }
__device__ __forceinline__ unsigned xb_add(unsigned* p, unsigned v) { return __hip_atomic_fetch_add(p, v, __ATOMIC_RELAXED, __HIP_MEMORY_SCOPE_AGENT); }
__device__ __forceinline__ unsigned xb_xcc_id() { return (unsigned)__builtin_amdgcn_s_getreg((3 << 11) | 20) & 0xFu; }
#define XB_SPIN(cond, bar) do { unsigned _sp = 0; while (cond) { __builtin_amdgcn_s_sleep(1); \
    if ((++_sp & 255u) == 0u) { if (xb_ld(&(bar)[XB_TMO])) break; if (_sp > XB_SPIN_CAP) { atomicAdd(&(bar)[XB_TMO], 1u); break; } } } } while (0)

struct XcdBarrier {
    unsigned* bar; unsigned x;
    volatile LAS unsigned* st;
};

__device__ __forceinline__ XcdBarrier xcd_barrier_post(unsigned* bar, volatile LAS unsigned* st, bool leader  ) {
    XcdBarrier b; b.bar = bar; b.x = xb_xcc_id(); b.st = st;
    if (leader) (void)xb_add(&bar[XB_XCNT(b.x)], 1u);
    return b;
}
__device__ __forceinline__ void xcd_barrier_complete(unsigned* bar, unsigned x, unsigned& nloc, unsigned& nx) {
    const unsigned G = gridDim.x * gridDim.y * gridDim.z;
    unsigned sum, cnt, mine, sp = 0u;
    for (;;) {
        sum = 0u; cnt = 0u; mine = 0u;
#pragma unroll
        for (unsigned j = 0; j < 16; ++j) { const unsigned c = xb_ld(&bar[XB_XCNT(j)]); sum += c; cnt += (c > 0u) ? 1u : 0u; mine = (j == x) ? c : mine; }
        if (sum == G) break;
        __builtin_amdgcn_s_sleep(1);
        if ((++sp & 255u) == 0u) { if (xb_ld(&bar[XB_TMO])) break; if (sp > XB_SPIN_CAP) { atomicAdd(&bar[XB_TMO], 1u); break; } }
    }
    nloc = mine > 0u ? mine : 1u; nx = cnt > 0u ? cnt : 1u;
}

__device__ __forceinline__ void xcd_barrier(const XcdBarrier& b, bool leader) {
    asm volatile("s_waitcnt vmcnt(0)" ::: "memory");
    __syncthreads();
    if (leader) {
        unsigned* bar = b.bar;
        __builtin_amdgcn_s_waitcnt(0);
        unsigned nloc = b.st[0], nx = b.st[1];
        if (nloc == 0u) { xcd_barrier_complete(bar, b.x, nloc, nx); b.st[0] = nloc; b.st[1] = nx; }
        const unsigned old = xb_add(&bar[XB_XSUB(b.x)], 1u);
        const unsigned gen = old / nloc;
        if (old + 1u == (gen + 1u) * nloc) {
            __builtin_amdgcn_fence(__ATOMIC_RELEASE, "agent");
            asm volatile("s_waitcnt vmcnt(0)" ::: "memory");
            const unsigned og = xb_add(&bar[XB_TOP], 1u);
            const unsigned tg = og / nx;
            if (og + 1u == (tg + 1u) * nx) xb_add(&bar[XB_TOPGEN], 1u);
            else XB_SPIN(xb_ld(&bar[XB_TOPGEN]) == tg, bar);
            __builtin_amdgcn_fence(__ATOMIC_ACQUIRE, "agent");
            xb_add(&bar[XB_XGEN(b.x)], 1u);
            asm volatile("s_waitcnt vmcnt(0)" ::: "memory");
        } else {
            XB_SPIN(xb_ld(&bar[XB_XGEN(b.x)]) == gen, bar);
            __builtin_amdgcn_fence(__ATOMIC_ACQUIRE, "agent");
            asm volatile("s_waitcnt vmcnt(0)" ::: "memory");
        }
    }
    __syncthreads();
}

typedef __hip_bfloat16 bf16h;
struct Args { const float* in[23]; float* out; unsigned char* ws; int ph_lo, ph_hi; };

__device__ __forceinline__ float wave_sum(float v, int lane) {
#pragma unroll
    for (int o = 1; o < 64; o <<= 1) v += shx(v, o, lane);
    return v;
}
__device__ __forceinline__ float bflo(unsigned w) { return __uint_as_float(w << 16); }
__device__ __forceinline__ float bfhi(unsigned w) { return __uint_as_float(w & 0xffff0000u); }
__device__ __forceinline__ unsigned pkh(float lo, float hi) { return pg8::cvt_pk_f16(lo, hi); }
__device__ __forceinline__ unsigned cvtpk2(float lo, float hi) { unsigned r; asm volatile("v_cvt_pk_bf16_f32 %0, %1, %2" : "=v"(r) : "v"(lo), "v"(hi)); return r; }

constexpr int CTX_OFF = LDSCTL_OFF + 2048;
__device__ __forceinline__ unsigned char* ctxp(LAS unsigned char* ldsl, int i) {
    const unsigned long long v = *(volatile LAS unsigned long long*)(ldsl + CTX_OFF + 8 * i);
    const unsigned long long u = ((unsigned long long)(unsigned)__builtin_amdgcn_readfirstlane((int)(v >> 32)) << 32) | (unsigned long long)(unsigned)__builtin_amdgcn_readfirstlane((int)(unsigned)v);
    return (unsigned char*)(GAS unsigned char*)u;
}
__device__ __forceinline__ int map_row(int n, int mode) {
    if (mode == 1) { const int half = n >= FF ? 1 : 0, j = n - half * FF; return (j >> 7) * 256 + half * 128 + (j & 127); }
    if (mode == 2) { if (n < DM) return 2 * DM + n; const int half = n >= 2 * DM ? 1 : 0, j = n - DM - half * DM; return (j >> 7) * 256 + half * 128 + (j & 127); }
    return n;
}
__device__ __forceinline__ void p0_transpose_item(const float* W, const float* gain, int K, int N, bf16* WT, int mode, LAS float* scr, int item, int lane) {
    const int nblk = N >> 6, kb = item / nblk, nb = item - kb * nblk, k0 = 64 * kb, n0 = 64 * nb, d0 = map_row(n0, mode);
    const int r4 = lane >> 4, cg = lane & 15;
    const GAS f32x4* src = (const GAS f32x4*)(W + (size_t)(k0 + r4) * N + n0) + cg;
    f32x4 v[16];
#pragma unroll
    for (int i = 0; i < 16; ++i) v[i] = src[(size_t)i * N];
    if (gain) {
#pragma unroll
        for (int i = 0; i < 16; ++i) v[i] = v[i] * gain[k0 + 4 * i + r4]; }
    LAS float* wp = scr + r4 * 65 + 4 * cg;
#pragma unroll
    for (int i = 0; i < 16; ++i) { wp[(4 * i) * 65 + 0] = v[i].x; wp[(4 * i) * 65 + 1] = v[i].y; wp[(4 * i) * 65 + 2] = v[i].z; wp[(4 * i) * 65 + 3] = v[i].w; }
    LDS_WAIT(); asm volatile("" ::: "memory");
    const int c = lane & 7;
#pragma unroll
    for (int j = 0; j < 8; ++j) { const int n = (lane >> 3) + 8 * j; const LAS float* s = scr + (8 * c) * 65 + n;
        v4u o; o.x = pk2(s[0 * 65], s[1 * 65]); o.y = pk2(s[2 * 65], s[3 * 65]); o.z = pk2(s[4 * 65], s[5 * 65]); o.w = pk2(s[6 * 65], s[7 * 65]);
        *(GAS v4u*)(WT + (size_t)(d0 + n) * K + k0 + 8 * c) = o; }
    LDS_WAIT(); asm volatile("" ::: "memory");
}
struct WJob { const float* W; const float* gain; bf16* dst; int K, N, mode; };
#define CTX_IN(i) ((const float*)ctxp(ldsl, (i)))
__device__ __forceinline__ WJob get_job(LAS unsigned char* ldsl, int j) {
    const int l = j >> 3, t = j & 7, kind = l % 3, jj = l / 3; bf16* wl = (bf16*)(ctxp(ldsl, 24) + WS_W) + (size_t)l * WL_SIZE; WJob r;
    if (t == 0)      { r.W = CTX_IN(3) + (size_t)l * DM * 2 * FF;  r.gain = CTX_IN(2) + l * DM;  r.dst = wl + WL_FFN1_IN;  r.K = DM;  r.N = 2 * FF; r.mode = 1; }
    else if (t == 1) { r.W = CTX_IN(4) + (size_t)l * FF * DM;      r.gain = nullptr;           r.dst = wl + WL_FFN1_OUT; r.K = FF;  r.N = DM;     r.mode = 0; }
    else if (t == 2) { r.W = CTX_IN(16) + (size_t)l * DM * 2 * FF; r.gain = CTX_IN(15) + l * DM; r.dst = wl + WL_FFN2_IN;  r.K = DM;  r.N = 2 * FF; r.mode = 1; }
    else if (t == 3) { r.W = CTX_IN(17) + (size_t)l * FF * DM;     r.gain = nullptr;           r.dst = wl + WL_FFN2_OUT; r.K = FF;  r.N = DM;     r.mode = 0; }
    else if (t == 4) { r.W = CTX_IN(19) + (size_t)l * DM * DM;     r.gain = CTX_IN(18) + l * DM; r.dst = wl + WL_PLE_G;    r.K = DM;  r.N = DM;     r.mode = 0; }
    else if (t == 5) { r.W = CTX_IN(21) + (size_t)l * PLE * DM;    r.gain = nullptr;           r.dst = wl + WL_PLE_P;    r.K = PLE; r.N = DM;     r.mode = 0; }
    else if (t == 6) { r.gain = CTX_IN(5) + l * DM; r.dst = wl + WL_MIX_IN; r.K = DM;
        if (kind == 0)      { r.W = CTX_IN(6) + (size_t)jj * DM * NA;  r.N = NA; r.mode = 0; }
        else if (kind == 1) { r.W = CTX_IN(8) + (size_t)jj * DM * NB;  r.N = NB; r.mode = 0; }
        else                { r.W = CTX_IN(12) + (size_t)jj * DM * NC; r.N = NC; r.mode = 2; } }
    else { r.gain = nullptr; r.dst = wl + WL_MIX_OUT; r.K = DM; r.N = DM; r.mode = 0;
        r.W = (kind == 0 ? CTX_IN(7) : (kind == 1 ? CTX_IN(9) : CTX_IN(14))) + (size_t)jj * DM * DM; }
    return r;
}
__device__ __forceinline__ void p0_prologue(LAS unsigned char* ldsl, int wave, int lane, int G) {
    LAS unsigned char* lds = ldsl; unsigned char* wsb = ctxp(ldsl, 24);
    LAS float* scr = (LAS float*)(lds + RING_OFF + wave * 16640);
    const int gw = (int)blockIdx.x * NWAVES + wave, NGW = G * NWAVES;
    long base = 0;
    for (int j = 0; j < 8 * DEPTH; ++j) {
        const WJob jb = get_job(ldsl, j); const int nitems = (jb.K / 64) * (jb.N / 64);
        int start = (int)(((long)gw - base) % NGW); if (start < 0) start += NGW;
        for (int it = start; it < nitems; it += NGW) p0_transpose_item(jb.W, jb.gain, jb.K, jb.N, jb.dst, jb.mode, scr, it, lane);
        base += nitems;
    }
    bf16* HB = (bf16*)(wsb + WS_HB0); bf16* LOB = (bf16*)(wsb + WS_H16); float* SSQ = (float*)(wsb + WS_SSQ0); const float* xin = CTX_IN(0);
    for (int m = gw; m < M; m += NGW) {
        const GAS f32x4* xr = (const GAS f32x4*)(xin + (size_t)m * DM) + lane;
        GAS unsigned long long* o8 = (GAS unsigned long long*)(HB + (size_t)m * DM) + lane; GAS unsigned long long* l8 = (GAS unsigned long long*)(LOB + (size_t)m * DM) + lane; float s = 0.f;
#pragma unroll
        for (int j = 0; j < 8; ++j) { const f32x4 v = xr[64 * j]; s += (v.x * v.x + v.y * v.y) + (v.z * v.z + v.w * v.w);
            const unsigned w0 = pk2(v.x, v.y), w1 = pk2(v.z, v.w); o8[64 * j] = (unsigned long long)w0 | ((unsigned long long)w1 << 32);
            l8[64 * j] = (unsigned long long)pkh(v.x, v.y) | ((unsigned long long)pkh(v.z, v.w) << 32); }
        s = wave_sum(s, lane);
        if (lane < 32) SSQ[((size_t)(lane >> 2) * M + m) * 4 + (lane & 3)] = lane == 0 ? s : 0.f;
    }
    { const GAS f32x4* p4 = (const GAS f32x4*)CTX_IN(1); GAS v4u* o = (GAS v4u*)(wsb + WS_PB); const long nch = (long)DEPTH * M * PLE / 8;
      for (long i = (long)gw * 64 + lane; i < nch; i += (long)NGW * 64) { const f32x4 v0 = p4[2 * i], v1 = p4[2 * i + 1]; v4u w; w.x = pk2(v0.x, v0.y); w.y = pk2(v0.z, v0.w); w.z = pk2(v1.x, v1.y); w.w = pk2(v1.z, v1.w); o[i] = w; } }
}

static_assert(pg8::SSQ_ROWS == M && pg8::SSQ_DM == DM && pg8::SSQ_EPS == RMS_EPS, "SSQ layout");

constexpr int CW_GRP = 16384;
__device__ __forceinline__ void group_barrier(gu32* ctl, int pm, unsigned target, volatile LAS unsigned* lflag, bool leader) {
    asm volatile("s_waitcnt vmcnt(0)" ::: "memory");
    __syncthreads();
    if (leader) {
        gu32* cnt = ctl + CW_GRP + 64 * pm; gu32* tmo = ctl + CW_BAR + XB_TMO;
        const unsigned st = lflag[0];
        if (st != 2u) { __builtin_amdgcn_fence(__ATOMIC_RELEASE, "agent"); asm volatile("s_waitcnt vmcnt(0)" ::: "memory"); }
        __hip_atomic_fetch_add(cnt, 1u, RLX_AGENT);
        unsigned sp = 0u;
        while (__hip_atomic_load(cnt, RLX_AGENT) < target) { __builtin_amdgcn_s_sleep(1);
            if ((++sp & 255u) == 0u) { if (__hip_atomic_load(tmo, RLX_AGENT)) break; if (sp > XB_SPIN_CAP) { __hip_atomic_fetch_add(tmo, 1u, RLX_AGENT); break; } } }
        __builtin_amdgcn_fence(__ATOMIC_ACQUIRE, "agent");
        asm volatile("s_waitcnt vmcnt(0)" ::: "memory");
        if (st == 0u) { const unsigned x0 = __hip_atomic_load(cnt + 8, RLX_AGENT), x1 = __hip_atomic_load(cnt + 9, RLX_AGENT), x2 = __hip_atomic_load(cnt + 10, RLX_AGENT), x3 = __hip_atomic_load(cnt + 11, RLX_AGENT);
            lflag[0] = (x0 != 0u && x0 == x1 && x0 == x2 && x0 == x3) ? 2u : 1u; }
    }
    __syncthreads();
}

__device__ __forceinline__ swa::BlockRef a_ref(int n, int c, const bf16h* QKV, bf16h* OT, float* LSE) {
    const int g = n >> 2, k = n & 3, dil = g == 0 ? 1 : (g == 1 ? 4 : 16), npb = 128 / dil;
    int idx = c * 4 + k; const int pb = idx % npb; idx /= npb; const int kvh = idx & 3; idx >>= 2; const int r = idx % dil, b = idx / dil;
    const size_t row0 = (size_t)b * SEQ + r, rowq = row0 + (size_t)dil * 64 * pb;
    swa::BlockRef R; R.Q = QKV + rowq * NQ + kvh * 4 * HD; R.K = QKV + row0 * NQ + DM + ((g * 2 + 0) * 4 + kvh) * HD; R.V = QKV + row0 * NQ + DM + ((g * 2 + 1) * 4 + kvh) * HD;
    R.O = OT + (size_t)g * M * DM + rowq * DM + kvh * 4 * HD; R.L = LSE + (size_t)g * M * 16 + rowq * 16 + kvh * 4; R.P0 = 64 * pb; R.skv = SEQ / dil; R.qs = dil * NQ; R.kvs = dil * NQ; R.os = dil * DM; R.ls = dil * 16;
    R.span = 64; R.wpb = 2; R.qsub = HD; R.osub = HD; R.lsub = 1;
    return R;
}
__device__ __forceinline__ swa::BlockRef b_ref(int n, int c, const bf16h* QKV, bf16h* OT) {
    const int x = c & 7, j = c >> 3, it = n >> 1, pass = n & 1, combo = x * 8 + 2 * it + (j >> 4), y = j & 15, qb = pass ? 31 - y : y;
    const int vhalf = combo & 1, cc = (combo >> 1) & 1, h = (combo >> 2) & 7, b = combo >> 5; const size_t row0 = (size_t)b * SEQ, rowq = row0 + 256 * qb;
    swa::BlockRef R; R.Q = QKV + rowq * NQ + h * 256 + cc * HD; R.K = QKV + row0 * NQ + DM + h * 256 + cc * HD; R.V = QKV + row0 * NQ + 2 * DM + h * 256 + vhalf * HD;
    R.O = OT + (size_t)cc * M * DM + rowq * DM + h * 256 + vhalf * HD; R.L = nullptr; R.P0 = 256 * qb; R.skv = SEQ; R.qs = NQ; R.kvs = NQ; R.os = DM; R.ls = 0; R.span = 256; R.wpb = 8; R.qsub = 0; R.osub = 0; R.lsub = 0;
    return R;
}

__device__ __forceinline__ swa::DRef bd_ref(int n, int c, const bf16h* QKV, bf16h* OT) {
    const int x = c & 7, j = c >> 3, prob = 4 * x + (n >> 1), cc = prob & 1, h = (prob >> 1) & 7, b = prob >> 4, qb = (n & 1) ? 63 - j : j;
    const unsigned row0 = (unsigned)(b * SEQ), rowq = row0 + (unsigned)(128 * qb);
    swa::DRef R; R.Q = QKV + (rowq * (unsigned)NQ + (unsigned)(h * 256 + cc * HD)); R.K = QKV + (row0 * (unsigned)NQ + (unsigned)(DM + h * 256 + cc * HD)); R.V = QKV + (row0 * (unsigned)NQ + (unsigned)(2 * DM + h * 256));
    R.O = OT + ((unsigned)cc * (unsigned)(M * DM) + rowq * (unsigned)DM + (unsigned)(h * 256)); R.P0 = 128 * qb;
    return R;
}
__device__ __forceinline__ void dattn_phase_lower(int cwg, const bf16h* BIG, bf16h* OT, char* ring, swa::lds_u8* ringl, int wave_s) {
    swa::DSeam S; swa::DRef cur = bd_ref(0, cwg, BIG, OT), nxt;
    swa::dattn_prime(cur, NQ, NQ, ringl, S, wave_s);
    for (int n = 0; n < 8; ++n) { nxt = (n < 7) ? bd_ref(n + 1, cwg, BIG, OT) : cur; swa::dattn_block_lower(cur, nxt, NQ, ring, S, wave_s); cur = nxt; }
}
__device__ __forceinline__ void dattn_phase_upper(int cwg, const bf16h* BIG, bf16h* OT, char* ring, swa::lds_u8* ringl, int wave_s) {
    swa::DSeam S; swa::DRef cur = bd_ref(0, cwg, BIG, OT), nxt;
    swa::dattn_prime(cur, NQ, NQ, ringl, S, wave_s);
    for (int n = 0; n < 8; ++n) { nxt = (n < 7) ? bd_ref(n + 1, cwg, BIG, OT) : cur; swa::dattn_block_upper(cur, nxt, NQ, DM, ring, ringl, S, wave_s); cur = nxt; }
}
static_assert(swa::D_LDS_BYTES <= LDSCTL_OFF, "differential-attention LDS map");

__global__ void __launch_bounds__(NWAVES * 64, 2) mk_fwd(Args args) {
    extern __shared__ __attribute__((aligned(16))) unsigned char lds[];
    LAS unsigned char* ldsl = (LAS unsigned char*)lds;
    volatile LAS unsigned* MISC = (volatile LAS unsigned*)(ldsl + MISC_OFF);
    LAS float* rstab = (LAS float*)(ldsl + RSTD_OFF);
    const int wave_s = __builtin_amdgcn_readfirstlane((int)threadIdx.x >> 6);
    const int tid0 = wave_s * 64 + lane_id_v();
#define LEADER() (wave_s == 0 && lane_id_v() == 0)
#define PHASE_IDS() int tid = wave_s * 64 + lane_id_v(), cwg = blockIdx.x; asm volatile("" : "+v"(tid), "+s"(cwg)); const int lane = tid & 63, wave = __builtin_amdgcn_readfirstlane(tid >> 6), G = gridDim.x, \
        gw = cwg * NWAVES + wave, NGW = G * NWAVES, my_pm = (cwg & 7) * 8 + ((cwg >> 3) & 7); (void)lane; (void)gw; (void)NGW; (void)my_pm
    for (int u = tid0; u < (LDS_BYTES - LDSCTL_OFF) / 4; u += NWAVES * 64) ((LAS unsigned*)(ldsl + LDSCTL_OFF))[u] = 0u;
    __syncthreads();
    if (tid0 == 0) { LAS unsigned long long* cx = (LAS unsigned long long*)(ldsl + CTX_OFF);
#pragma unroll
        for (int i = 0; i < 23; ++i) cx[i] = (unsigned long long)(uintptr_t)args.in[i];
        cx[23] = (unsigned long long)(uintptr_t)args.out; cx[24] = (unsigned long long)(uintptr_t)args.ws; }
    __syncthreads();
    if (!MK_PER_PHASE) (void)xcd_barrier_post((unsigned*)(ctxp(ldsl, 24) + WS_CTL) + CW_BAR, MISC + 8, tid0 == 0);
    if (!MK_PER_PHASE && tid0 == 0) { const int c_ = blockIdx.x; __hip_atomic_store((gu32*)(ctxp(ldsl, 24) + WS_CTL) + CW_GRP + 64 * ((c_ & 7) * 8 + ((c_ >> 3) & 7)) + 8 + (c_ >> 6), xb_xcc_id() + 1u, RLX_AGENT); }
    const int lo = args.ph_lo, hi = args.ph_hi;
    int ph = 0, par = 0;
#define IN_() (lo <= ph && ph < hi)
#define SEAM() do { if (!MK_PER_PHASE && lo <= ph && ph + 1 < hi) { XcdBarrier b_; b_.bar = (unsigned*)(ctxp(ldsl, 24) + WS_CTL) + CW_BAR; b_.x = xb_xcc_id(); b_.st = MISC + 8; xcd_barrier(b_, LEADER()); } ++ph; } while (0)
#define WSP() ctxp(ldsl, 24)
    unsigned gk = 0u;
#define SEAM_G() do { if (!MK_PER_PHASE && lo <= ph && ph + 1 < hi) { int c_ = blockIdx.x; asm volatile("" : "+s"(c_)); ++gk; group_barrier((gu32*)(ctxp(ldsl, 24) + WS_CTL), (c_ & 7) * 8 + ((c_ >> 3) & 7), 4u * gk, MISC + 12, LEADER()); } ++ph; } while (0)

    if (IN_()) { PHASE_IDS(); p0_prologue(ldsl, wave, lane, G); }
    SEAM();

    for (int pr = 0; pr < 4 * DEPTH; ++pr) {
        const int l = pr >> 2, sub = pr & 3, kind = l % 3, jj = l / 3;
        if (sub != 3 && IN_()) {
            PHASE_IDS();
            unsigned char* ws = WSP(); bf16h* BIG = (bf16h*)(ws + WS_BIG); bf16h* OT = (bf16h*)(ws + WS_OT);
            const pg8::bf16_t* wl = (const pg8::bf16_t*)(ws + WS_W) + (size_t)l * WL_SIZE;
            const pg8::bf16_t* hb_cur = (const pg8::bf16_t*)(ws + (par ? WS_HB1 : WS_HB0));
            const float* ssq_cur = (const float*)(ws + (par ? WS_SSQ1 : WS_SSQ0));
            pg8::Gemm g; pg8::XEpi E; g.M = M; g.lda = DM; E.rs = rstab; E.use_rstd = 1; E.act = 0; E.nglu = 0; E.O1 = (pg8::bf16_t*)BIG; E.ld1 = NQ; E.O2 = (pg8::bf16_t*)BIG; E.ld2 = NQ;
            if (sub == 0 || sub == 2) { g.A = hb_cur; g.Bt = wl + (sub == 0 ? WL_FFN1_IN : WL_FFN2_IN); g.N = 2 * FF; g.K = DM; E.nglu = 2 * FF / 256; E.act = 1; }
            else if (sub == 1) { g.A = hb_cur; g.Bt = wl + WL_MIX_IN; g.K = DM;
                if (kind == 0) { g.N = NA; } else if (kind == 1) { g.N = NB; }
                else { g.N = NC; E.nglu = 16; E.O1 = (pg8::bf16_t*)OT; E.ld1 = DM; E.O2 = (pg8::bf16_t*)(OT + (size_t)M * DM); E.ld2 = DM; } }
            E.tssq = ssq_cur; E.tpm = my_pm; E.tw = rstab;
            const int ncall = sub == 2 ? 2 : 1;
            for (int call = 0; call < ncall; ++call) {
                if (call == 1) { g.A = (const pg8::bf16_t*)(ws + WS_PB) + (size_t)l * M * PLE; g.lda = PLE; g.Bt = wl + WL_PLE_P; g.N = DM; g.K = PLE; E.use_rstd = 0; E.tssq = nullptr; E.nglu = 0; E.O2 = (pg8::bf16_t*)(OT + (size_t)2 * M * DM); E.ld2 = DM; }
                pg8::PanelOrder S; S.init(g.N, G, cwg);
                pg8::gemm_phase<pg8::XEpi, pg8::PanelOrder, true, true>(ldsl + RING_OFF, g, S, E, tid);
            }
        }
        if (sub == 1) SEAM(); else if (sub != 3) SEAM_G();
        if (sub == 1) {
            if (kind == 0) {
                if (IN_()) {
                    PHASE_IDS();
                    unsigned char* ws = WSP(); const bf16h* BIG = (const bf16h*)(ws + WS_BIG); bf16h* OT = (bf16h*)(ws + WS_OT); float* LSE = (float*)(ws + WS_LSE);
                    swa::Seam S; swa::BlockRef cur = a_ref(0, cwg, BIG, OT, LSE), nxt;
                    swa::causal_swa_prime(cur, 129, (char*)lds + RING_OFF, (swa::lds_u8*)(ldsl + RING_OFF), S, wave_s);
                    asm volatile("s_cmp_lt_u32 %0, 4\n\ts_cbranch_scc1 .Lsp%=\n\ts_setprio 1\n.Lsp%=:" :: "s"(wave) : "scc");
                    for (int n = 0; n < 12; ++n) { nxt = (n < 11) ? a_ref(n + 1, cwg, BIG, OT, LSE) : cur; swa::causal_swa_block<true>(cur, nxt, 129, (char*)lds + RING_OFF, (swa::lds_u8*)(ldsl + RING_OFF), S, wave_s); cur = nxt; }
                    swa::causal_swa_finish();
                }
                SEAM();
                if (IN_()) {
                    PHASE_IDS();
                    unsigned char* ws = WSP(); const bf16h* OT = (const bf16h*)(ws + WS_OT); bf16h* AO = (bf16h*)(ws + WS_AO); const float* LSE = (const float*)(ws + WS_LSE);
                    for (int i = 0; i < 8; ++i) { const int m = my_pm * 256 + (cwg >> 6) * 64 + wave * 8 + i;
#pragma unroll
                        for (int j = 0; j < 4; ++j) { const int c = lane + 64 * j, head = c >> 4;
                            const float l0 = LSE[(size_t)m * 16 + head], l1 = LSE[(size_t)(M + m) * 16 + head], l2 = LSE[(size_t)(2 * M + m) * 16 + head];
                            const float mx = fmaxf(l0, fmaxf(l1, l2)); float w0 = __builtin_amdgcn_exp2f(l0 - mx), w1 = __builtin_amdgcn_exp2f(l1 - mx), w2 = __builtin_amdgcn_exp2f(l2 - mx);
                            const float inv = 1.0f / (w0 + w1 + w2); w0 *= inv; w1 *= inv; w2 *= inv;
                            const v4u a = *(const v4u*)(OT + (size_t)m * DM + 8 * c), b = *(const v4u*)(OT + (size_t)(M + m) * DM + 8 * c), d = *(const v4u*)(OT + (size_t)(2 * M + m) * DM + 8 * c);
                            v4u o;
                            o.x = cvtpk2(w0 * bflo(a.x) + w1 * bflo(b.x) + w2 * bflo(d.x), w0 * bfhi(a.x) + w1 * bfhi(b.x) + w2 * bfhi(d.x));
                            o.y = cvtpk2(w0 * bflo(a.y) + w1 * bflo(b.y) + w2 * bflo(d.y), w0 * bfhi(a.y) + w1 * bfhi(b.y) + w2 * bfhi(d.y));
                            o.z = cvtpk2(w0 * bflo(a.z) + w1 * bflo(b.z) + w2 * bflo(d.z), w0 * bfhi(a.z) + w1 * bfhi(b.z) + w2 * bfhi(d.z));
                            o.w = cvtpk2(w0 * bflo(a.w) + w1 * bflo(b.w) + w2 * bflo(d.w), w0 * bfhi(a.w) + w1 * bfhi(b.w) + w2 * bfhi(d.w));
                            *(v4u*)(AO + (size_t)m * DM + 8 * c) = o; }
                    }
                }
                SEAM_G();
            } else if (kind == 1) {
                if (IN_()) {
                    PHASE_IDS();
                    unsigned char* ws = WSP(); const bf16h* BIG = (const bf16h*)(ws + WS_BIG); bf16h* OT = (bf16h*)(ws + WS_OT);
                    if (wave >= 4) dattn_phase_upper(cwg, BIG, OT, (char*)lds + RING_OFF, (swa::lds_u8*)(ldsl + RING_OFF), wave_s); else dattn_phase_lower(cwg, BIG, OT, (char*)lds + RING_OFF, (swa::lds_u8*)(ldsl + RING_OFF), wave_s);
                    swa::causal_swa_finish();
                }
                SEAM();
                if (IN_()) {
                    PHASE_IDS();
                    unsigned char* ws = WSP(); const bf16h* OT = (const bf16h*)(ws + WS_OT); bf16h* AO = (bf16h*)(ws + WS_AO);
                    const float* lp = CTX_IN(10) + (size_t)jj * 4 * HD; const float* sg = CTX_IN(11) + (size_t)jj * 2 * HD;
                    float s1 = lp[lane] * lp[HD + lane] + lp[64 + lane] * lp[HD + 64 + lane], s2 = lp[2 * HD + lane] * lp[3 * HD + lane] + lp[2 * HD + 64 + lane] * lp[3 * HD + 64 + lane];
                    s1 = wave_sum(s1, lane); s2 = wave_sum(s2, lane);
                    const float lam_init = 0.8f - 0.6f * expf(-0.3f * (float)l), lam = expf(s1) - expf(s2) + lam_init, post = 1.0f - lam_init;
                    for (int i = 0; i < 8; ++i) { const int m = my_pm * 256 + (cwg >> 6) * 64 + wave * 8 + i;
#pragma unroll
                        for (int j = 0; j < 4; ++j) { const int oc = 8 * (lane + 64 * j), jc = oc & 255;
                            const v4u a = *(const v4u*)(OT + (size_t)m * DM + oc), b = *(const v4u*)(OT + (size_t)(M + m) * DM + oc);
                            float d[8]; d[0] = bflo(a.x) - lam * bflo(b.x); d[1] = bfhi(a.x) - lam * bfhi(b.x); d[2] = bflo(a.y) - lam * bflo(b.y); d[3] = bfhi(a.y) - lam * bfhi(b.y);
                            d[4] = bflo(a.z) - lam * bflo(b.z); d[5] = bfhi(a.z) - lam * bfhi(b.z); d[6] = bflo(a.w) - lam * bflo(b.w); d[7] = bfhi(a.w) - lam * bfhi(b.w);
                            float ss = (d[0] * d[0] + d[1] * d[1]) + (d[2] * d[2] + d[3] * d[3]) + (d[4] * d[4] + d[5] * d[5]) + (d[6] * d[6] + d[7] * d[7]);
                            ss += shx(ss, 1, lane); ss += shx(ss, 2, lane); ss += shx(ss, 4, lane); ss += shx(ss, 8, lane); ss += shx(ss, 16, lane);
                            const float r = post / sqrtf(ss * (1.0f / 256.0f) + SUBLN_EPS);
                            const f32x4 g0 = *(const f32x4*)(sg + jc), g1 = *(const f32x4*)(sg + jc + 4);
                            v4u o; o.x = cvtpk2(d[0] * r * g0.x, d[1] * r * g0.y); o.y = cvtpk2(d[2] * r * g0.z, d[3] * r * g0.w); o.z = cvtpk2(d[4] * r * g1.x, d[5] * r * g1.y); o.w = cvtpk2(d[6] * r * g1.z, d[7] * r * g1.w);
                            *(v4u*)(AO + (size_t)m * DM + oc) = o; }
                    }
                }
                SEAM_G();
            } else {
                if (IN_()) { PHASE_IDS();
                    unsigned char* ws = WSP(); const bf16h* OT = (const bf16h*)(ws + WS_OT); const bf16h* BIG = (const bf16h*)(ws + WS_BIG); bf16h* AO = (bf16h*)(ws + WS_AO);
                    const float* cw = CTX_IN(13) + (size_t)jj * 3 * DM;
                    for (int i = 0; i < 8; ++i) { const int m = my_pm * 256 + (cwg >> 6) * 64 + wave * 8 + i; const int t = m & (SEQ - 1);
#pragma unroll
                        for (int j = 0; j < 4; ++j) { const int col = 8 * (lane + 64 * j);
                            const v4u z0 = *(const v4u*)(OT + (size_t)m * DM + col); v4u z1 = {0u, 0u, 0u, 0u}, z2 = {0u, 0u, 0u, 0u};
                            if (t >= 1) z1 = *(const v4u*)(OT + (size_t)(m - 1) * DM + col);
                            if (t >= 2) z2 = *(const v4u*)(OT + (size_t)(m - 2) * DM + col);
                            const v4u bg = *(const v4u*)(OT + (size_t)(M + m) * DM + col);
                            const f32x4 wa0 = *(const f32x4*)(cw + col), wa1 = *(const f32x4*)(cw + col + 4), wb0 = *(const f32x4*)(cw + DM + col), wb1 = *(const f32x4*)(cw + DM + col + 4),
                                        wc0 = *(const f32x4*)(cw + 2 * DM + col), wc1 = *(const f32x4*)(cw + 2 * DM + col + 4);
                            v4u o;
                            o.x = cvtpk2(bflo(bg.x) * (wa0.x * bflo(z2.x) + wb0.x * bflo(z1.x) + wc0.x * bflo(z0.x)), bfhi(bg.x) * (wa0.y * bfhi(z2.x) + wb0.y * bfhi(z1.x) + wc0.y * bfhi(z0.x)));
                            o.y = cvtpk2(bflo(bg.y) * (wa0.z * bflo(z2.y) + wb0.z * bflo(z1.y) + wc0.z * bflo(z0.y)), bfhi(bg.y) * (wa0.w * bfhi(z2.y) + wb0.w * bfhi(z1.y) + wc0.w * bfhi(z0.y)));
                            o.z = cvtpk2(bflo(bg.z) * (wa1.x * bflo(z2.z) + wb1.x * bflo(z1.z) + wc1.x * bflo(z0.z)), bfhi(bg.z) * (wa1.y * bfhi(z2.z) + wb1.y * bfhi(z1.z) + wc1.y * bfhi(z0.z)));
                            o.w = cvtpk2(bflo(bg.w) * (wa1.z * bflo(z2.w) + wb1.z * bflo(z1.w) + wc1.z * bflo(z0.w)), bfhi(bg.w) * (wa1.w * bfhi(z2.w) + wb1.w * bfhi(z1.w) + wc1.w * bfhi(z0.w)));
                            *(v4u*)(AO + (size_t)m * DM + col) = o; }
                    }
                }
                SEAM_G();
            }
        }
        if (IN_()) {
            PHASE_IDS();
            unsigned char* ws = WSP(); const bf16h* BIG = (const bf16h*)(ws + WS_BIG); const bf16h* AO = (const bf16h*)(ws + WS_AO); const bf16h* OT = (const bf16h*)(ws + WS_OT);
            const pg8::bf16_t* wl = (const pg8::bf16_t*)(ws + WS_W) + (size_t)l * WL_SIZE;
            const pg8::bf16_t* hb_cur = (const pg8::bf16_t*)(ws + (par ? WS_HB1 : WS_HB0));
            const float* ssq_cur = (const float*)(ws + (par ? WS_SSQ1 : WS_SSQ0));
            pg8::Gemm g; pg8::REpi E; g.M = M; g.N = DM; g.lda = DM; E.H16 = (pg8::bf16_t*)(ws + WS_H16); E.HBin = hb_cur; E.rd16 = pr <= RES16_PAIRS ? 1 : 0; E.wr16 = pr < RES16_PAIRS ? 1 : 0; E.HB = (pg8::bf16_t*)(ws + (par ? WS_HB0 : WS_HB1)); E.SSQ = (float*)(ws + (par ? WS_SSQ0 : WS_SSQ1));
            E.scale = 1.f; E.mode = 0; E.PP = (const pg8::bf16_t*)(OT + (size_t)2 * M * DM); E.bias = CTX_IN(20) + (size_t)l * DM; E.rs = rstab;
            if (sub == 0 || sub == 2) { g.A = (const pg8::bf16_t*)BIG; g.lda = NQ; g.Bt = wl + (sub == 0 ? WL_FFN1_OUT : WL_FFN2_OUT); g.K = FF; E.scale = 0.5f; }
            else if (sub == 1) { g.A = (const pg8::bf16_t*)AO; g.Bt = wl + WL_MIX_OUT; g.K = DM; }
            else { g.A = hb_cur; g.Bt = wl + WL_PLE_G; g.K = DM; E.mode = 1; }
            E.tssq = E.mode ? ssq_cur : nullptr; E.tpm = my_pm; E.tw = rstab;
            pg8::PanelOrder S; S.init(DM, G, cwg);
            pg8::gemm_phase<pg8::REpi, pg8::PanelOrder, true, true>(ldsl + RING_OFF, g, S, E, tid);
        }
        par ^= 1;
        SEAM_G();
    }
    if (IN_()) {
        PHASE_IDS();
        unsigned char* ws = WSP(); const bf16h* HBf = (const bf16h*)(ws + (par ? WS_HB1 : WS_HB0)); float* outp = (float*)ctxp(ldsl, 23);
        const float* ssq = (const float*)(ws + (par ? WS_SSQ1 : WS_SSQ0)); const float* gf = CTX_IN(22);
        for (int i = 0; i < 8; ++i) { const int m = my_pm * 256 + (cwg >> 6) * 64 + wave * 8 + i;
            float s = lane < 32 ? ssq[((size_t)(lane >> 2) * M + m) * 4 + (lane & 3)] : 0.f; s = wave_sum(s, lane);
            const float rstd = 1.0f / sqrtf(s * (1.0f / DM) + RMS_EPS);
            GAS f32x4* orow = (GAS f32x4*)(outp + (size_t)m * DM); const f32x4* g4 = (const f32x4*)gf;
#pragma unroll
            for (int j = 0; j < 4; ++j) { const int c8 = lane + 64 * j;
                const v4u hw = *(const v4u*)(HBf + (size_t)m * DM + 8 * c8);
                const f32x4 ga = g4[2 * c8], gb = g4[2 * c8 + 1];
                orow[2 * c8] = (f32x4){bflo(hw.x) * rstd * ga.x, bfhi(hw.x) * rstd * ga.y, bflo(hw.y) * rstd * ga.z, bfhi(hw.y) * rstd * ga.w};
                orow[2 * c8 + 1] = (f32x4){bflo(hw.z) * rstd * gb.x, bfhi(hw.z) * rstd * gb.y, bflo(hw.w) * rstd * gb.z, bfhi(hw.w) * rstd * gb.w}; }
        }
    }
#undef IN_
#undef SEAM
#undef SEAM_G
#undef WSP
#undef PHASE_IDS
}

extern "C" void kernel_launch(void* const* d_in, const int* in_sizes, int n_in, void* d_out, int out_size, void* d_ws, size_t ws_size, hipStream_t stream) {
    static int grid = 0;
    if (grid == 0) {
        if (n_in != 23 || in_sizes[0] != M * DM || out_size != M * DM || ws_size < WS_END) {
            fprintf(stderr, "kernel_launch: built for 23 inputs, x/out of %d floats, >= %zu bytes of workspace; got n_in %d, in0 %d, out %d, ws %zu; nothing launched\n", M * DM, (size_t)WS_END, n_in, n_in > 0 ? in_sizes[0] : -1, out_size, ws_size); grid = -1; return; }
        int dev = 0, cus = 0, per_cu = 0;
        if (hipGetDevice(&dev) != hipSuccess || hipDeviceGetAttribute(&cus, hipDeviceAttributeMultiprocessorCount, dev) != hipSuccess) { fprintf(stderr, "kernel_launch: hipGetDevice / hipDeviceGetAttribute failed\n"); grid = -1; return; }
        if (hipFuncSetAttribute((const void*)mk_fwd, hipFuncAttributeMaxDynamicSharedMemorySize, LDS_BYTES) != hipSuccess) { fprintf(stderr, "kernel_launch: hipFuncSetAttribute failed\n"); grid = -1; return; }
        if (hipOccupancyMaxActiveBlocksPerMultiprocessor(&per_cu, (const void*)mk_fwd, NWAVES * 64, LDS_BYTES) != hipSuccess || per_cu < 1)
            fprintf(stderr, "kernel_launch: note: occupancy query reports %d workgroups per CU\n", per_cu);
        (void)hipGetLastError();
        grid = 256;
        if (cus < 256) { fprintf(stderr, "kernel_launch: device has %d CUs; this kernel needs 256 resident workgroups; nothing launched\n", cus); grid = -1; return; }
    }
    if (grid < 0) return;
    if (hipMemsetAsync((char*)d_ws + WS_CTL, 0, CTL_ZERO_BYTES, stream) != hipSuccess) { fprintf(stderr, "kernel_launch: hipMemsetAsync failed\n"); return; }
    Args a{};
    for (int i = 0; i < 23; ++i) a.in[i] = (const float*)d_in[i];
    a.out = (float*)d_out; a.ws = (unsigned char*)d_ws;
#if MK_PER_PHASE
    for (int li = 0; li < N_PHASES; ++li) { a.ph_lo = li; a.ph_hi = li + 1; hipLaunchKernelGGL(mk_fwd, dim3(grid), dim3(NWAVES * 64), LDS_BYTES, stream, a); }
#else
    a.ph_lo = 0; a.ph_hi = N_PHASES;
    hipLaunchKernelGGL(mk_fwd, dim3(grid), dim3(NWAVES * 64), LDS_BYTES, stream, a);
#endif
    const hipError_t le = hipPeekAtLastError();
    if (le != hipSuccess) fprintf(stderr, "kernel_launch: launch failed: %s\n", hipGetErrorName(le));
}
```

```cpp
#include <hip/hip_runtime.h>
#include <hip/hip_bf16.h>
#include <cstdio>
#include <cstdint>
#include <cmath>
__device__ __forceinline__ float shx(float v, int mask, int lane) { return __builtin_bit_cast(float, __builtin_amdgcn_ds_bpermute((lane ^ mask) << 2, __builtin_bit_cast(int, v))); }
__device__ __forceinline__ int lane_id_v() { int l; asm volatile("v_mbcnt_lo_u32_b32 %0, -1, 0\n\tv_mbcnt_hi_u32_b32 %0, -1, %0" : "=v"(l)); return l; }
namespace pg8 {
#define PG8_LAS __attribute__((address_space(3)))
typedef unsigned short bf16_t;
typedef short bf16x8 __attribute__((ext_vector_type(8)));
typedef float f32x4 __attribute__((ext_vector_type(4)));
typedef unsigned u32x4 __attribute__((ext_vector_type(4)));
constexpr int BM = 256, BK = 64, HALF = 128, HTB = HALF * BK * 2  , STAGE_BYTES = 8 * HTB, NXCD = 8, WGM = 8;

__host__ __device__ __forceinline__ int lds_byte(int r, int c) { const int st = (r >> 4) * 2 + (c >> 5), rr = r & 15, cc = c & 31, ob = rr * 64 + cc * 2; return st * 1024 + (ob ^ (((ob >> 9) & 1) << 5)); }
__host__ __device__ __forceinline__ void stage_rc(int b, int& R, int& C) { const int st = b / 1024, sb = b % 1024, swz = sb ^ (((sb >> 9) & 1) << 5); R = (st >> 1) * 16 + swz / 64; C = (st & 1) * 32 + (swz % 64) / 2; }
__host__ __device__ __forceinline__ int perm32(int rho) { const int n = rho >> 4, i = rho & 15; return 8 * (i >> 2) + 4 * n + (i & 3); }

struct Unit { int pm, pn; };
struct Gemm { const bf16_t* A; const bf16_t* Bt; int M, N, K, lda; };

__device__ __forceinline__ unsigned cvt_pk_bf16(float lo, float hi) { unsigned r; asm volatile("v_cvt_pk_bf16_f32 %0, %1, %2" : "=v"(r) : "v"(lo), "v"(hi)); return r; }
typedef _Float16 h16x2 __attribute__((ext_vector_type(2)));
typedef _Float16 h16x8 __attribute__((ext_vector_type(8)));
typedef float f32x2c __attribute__((ext_vector_type(2)));
__device__ __forceinline__ unsigned cvt_pk_f16(float lo, float hi) { const f32x2c v = {lo, hi}; return __builtin_bit_cast(unsigned, __builtin_convertvector(v, h16x2)); }
__device__ __forceinline__ f32x2c unpk_f16(unsigned w) { return __builtin_convertvector(__builtin_bit_cast(h16x2, w), f32x2c); }

struct PanelOrder {
    int nunits, G, c;
    __host__ __device__ void init(int N, int G_, int c_) { nunits = 64 * (N / BM); G = G_; c = c_; }
    __host__ __device__ bool next(int i, Unit& u) const {
        const long L = (long)i * G + c; if (L >= nunits) return false;
        u.pm = (int)((L & 7) * 8 + ((L >> 3) & 7)); u.pn = (int)(L >> 6); return true;
    }
    __device__ __forceinline__ void a_ready(const Unit&) const {}
    __device__ __forceinline__ void done(const Unit&) const {}
};

__device__ __forceinline__ float sigmoid_f(float x) { return __builtin_amdgcn_rcpf(1.0f + __builtin_amdgcn_exp2f(-1.4426950408889634f * x)); }
__device__ __forceinline__ f32x4 silu4(f32x4 g) { f32x4 r; r[0] = g[0] * sigmoid_f(g[0]); r[1] = g[1] * sigmoid_f(g[1]); r[2] = g[2] * sigmoid_f(g[2]); r[3] = g[3] * sigmoid_f(g[3]); return r; }
__device__ __forceinline__ f32x4 sig4(f32x4 g) { f32x4 r; r[0] = sigmoid_f(g[0]); r[1] = sigmoid_f(g[1]); r[2] = sigmoid_f(g[2]); r[3] = sigmoid_f(g[3]); return r; }

constexpr int SSQ_ROWS = 16384, SSQ_DM = 2048; constexpr float SSQ_EPS = 1e-6f;
__device__ __forceinline__ void rstd_table_pre(const float* ssq, int pm, PG8_LAS float* tab, int tid) {
    if (ssq != nullptr && tid < 256) { const f32x4* p = (const f32x4*)(ssq + (size_t)(pm * 256 + tid) * 4); f32x4 s = p[0];
#pragma unroll
        for (int k = 1; k < 8; ++k) s += p[(size_t)k * SSQ_ROWS];
        tab[tid] = 1.0f / sqrtf(((s[0] + s[1]) + (s[2] + s[3])) * (1.0f / SSQ_DM) + SSQ_EPS); }
}

struct XEpi {
    static constexpr bool PERM = true, AFTER_DRAIN = false;
    bf16_t* O1; int ld1; bf16_t* O2; int ld2; int nglu; int act; int use_rstd; const PG8_LAS float* rs; const float* tssq; int tpm; PG8_LAS float* tw;
    __device__ __forceinline__ void pre(int tid) const { rstd_table_pre(tssq, tpm, tw, tid); }
    __device__ __forceinline__ void operator()(const f32x4 (&acc)[2][2][4][2], const Unit& u, int wr, int wc, int fr, int fq) const {
        asm volatile("" : "+v"(fr), "+v"(fq));
        const int rl0 = wr * 64 + fr;
        if (u.pn < nglu) {
            bf16_t* base = O1 + (size_t)(u.pm * BM) * ld1 + u.pn * 128 + wc * 32 + 8 * fq;
#pragma unroll
            for (int ai = 0; ai < 2; ++ai)
#pragma unroll
                for (int m = 0; m < 4; ++m) { const int rl = rl0 + ai * HALF + m * 16; const float s = use_rstd ? rs[rl] : 1.f;
                    f32x4 g0 = acc[ai][0][m][0] * s, g1 = acc[ai][0][m][1] * s; const f32x4 u0 = acc[ai][1][m][0] * s, u1 = acc[ai][1][m][1] * s;
                    if (act) { g0 = silu4(g0); g1 = silu4(g1); }
                    const f32x4 v0 = g0 * u0, v1 = g1 * u1;
                    u32x4 w; w.x = cvt_pk_bf16(v0[0], v0[1]); w.y = cvt_pk_bf16(v0[2], v0[3]); w.z = cvt_pk_bf16(v1[0], v1[1]); w.w = cvt_pk_bf16(v1[2], v1[3]);
                    *(u32x4*)(base + (size_t)rl * ld1) = w; }
        } else {
            bf16_t* base = O2 + (size_t)(u.pm * BM) * ld2 + (u.pn - nglu) * BM + wc * 32 + 8 * fq;
#pragma unroll
            for (int ai = 0; ai < 2; ++ai)
#pragma unroll
                for (int m = 0; m < 4; ++m) { const int rl = rl0 + ai * HALF + m * 16; const float s = use_rstd ? rs[rl] : 1.f;
#pragma unroll
                    for (int bj = 0; bj < 2; ++bj) { const f32x4 v0 = acc[ai][bj][m][0] * s, v1 = acc[ai][bj][m][1] * s;
                        u32x4 w; w.x = cvt_pk_bf16(v0[0], v0[1]); w.y = cvt_pk_bf16(v0[2], v0[3]); w.z = cvt_pk_bf16(v1[0], v1[1]); w.w = cvt_pk_bf16(v1[2], v1[3]);
                        *(u32x4*)(base + (size_t)rl * ld2 + bj * HALF) = w; } }
        }
    }
};

struct REpi {
    static constexpr bool PERM = true, AFTER_DRAIN = false;
    bf16_t* H16; const bf16_t* HBin; int rd16, wr16  ; bf16_t* HB; float* SSQ; float scale; int mode; const bf16_t* PP; const float* bias; const PG8_LAS float* rs; const float* tssq; int tpm; PG8_LAS float* tw;
    __device__ __forceinline__ void pre(int tid) const { rstd_table_pre(tssq, tpm, tw, tid); }
    __device__ __forceinline__ void operator()(const f32x4 (&acc)[2][2][4][2], const Unit& u, int wr, int wc, int fr, int fq) const {
        asm volatile("" : "+v"(fr), "+v"(fq));
        constexpr int LD = 2048;
        const int rl0 = wr * 64 + fr, col0 = u.pn * BM + wc * 32 + 8 * fq;
        f32x4 bv[2][2];
#pragma unroll
        for (int bj = 0; bj < 2; ++bj)
#pragma unroll
            for (int n = 0; n < 2; ++n) bv[bj][n] = mode ? *(const f32x4*)(bias + col0 + bj * HALF + 4 * n) : (f32x4){0.f, 0.f, 0.f, 0.f};
        u32x4 hh[2][4][2];
#pragma unroll
        for (int ai = 0; ai < 2; ++ai)
#pragma unroll
            for (int m = 0; m < 4; ++m) { const size_t off = (size_t)(u.pm * BM + rl0 + ai * HALF + m * 16) * LD + col0;
#pragma unroll
                for (int bj = 0; bj < 2; ++bj) hh[ai][m][bj] = rd16 ? *(const u32x4*)(H16 + off + bj * HALF) : *(const u32x4*)(HBin + off + bj * HALF); }
#pragma unroll
        for (int ai = 0; ai < 2; ++ai) { float ssv[4];
#pragma unroll
            for (int m = 0; m < 4; ++m) { const int rl = rl0 + ai * HALF + m * 16; const int row = u.pm * BM + rl; const float s = mode ? rs[rl] : scale; float ss = 0.f;
#pragma unroll
                for (int bj = 0; bj < 2; ++bj) { const size_t off = (size_t)row * LD + col0 + bj * HALF;
                    f32x4 a0 = acc[ai][bj][m][0] * s, a1 = acc[ai][bj][m][1] * s;
                    if (mode) { const u32x4 pw = *(const u32x4*)(PP + off);
                        const f32x4 p0 = {__uint_as_float(pw.x << 16), __uint_as_float(pw.x & 0xffff0000u), __uint_as_float(pw.y << 16), __uint_as_float(pw.y & 0xffff0000u)};
                        const f32x4 p1 = {__uint_as_float(pw.z << 16), __uint_as_float(pw.z & 0xffff0000u), __uint_as_float(pw.w << 16), __uint_as_float(pw.w & 0xffff0000u)};
                        a0 = sig4(a0 + bv[bj][0]) * p0; a1 = sig4(a1 + bv[bj][1]) * p1; }
                    const u32x4 hw = hh[ai][m][bj]; f32x4 o0, o1;
                    if (rd16) { const f32x2c q0 = unpk_f16(hw.x), q1 = unpk_f16(hw.y), q2 = unpk_f16(hw.z), q3 = unpk_f16(hw.w); o0 = (f32x4){q0.x, q0.y, q1.x, q1.y}; o1 = (f32x4){q2.x, q2.y, q3.x, q3.y}; }
                    else { o0 = (f32x4){__uint_as_float(hw.x << 16), __uint_as_float(hw.x & 0xffff0000u), __uint_as_float(hw.y << 16), __uint_as_float(hw.y & 0xffff0000u)};
                           o1 = (f32x4){__uint_as_float(hw.z << 16), __uint_as_float(hw.z & 0xffff0000u), __uint_as_float(hw.w << 16), __uint_as_float(hw.w & 0xffff0000u)}; }
                    const f32x4 n0 = o0 + a0, n1 = o1 + a1;
                    if (wr16) { u32x4 wh; wh.x = cvt_pk_f16(n0[0], n0[1]); wh.y = cvt_pk_f16(n0[2], n0[3]); wh.z = cvt_pk_f16(n1[0], n1[1]); wh.w = cvt_pk_f16(n1[2], n1[3]);
                        *(u32x4*)(H16 + off) = wh; }
                    u32x4 w; w.x = cvt_pk_bf16(n0[0], n0[1]); w.y = cvt_pk_bf16(n0[2], n0[3]); w.z = cvt_pk_bf16(n1[0], n1[1]); w.w = cvt_pk_bf16(n1[2], n1[3]);
                    *(u32x4*)(HB + off) = w;
                    ss += (n0[0] * n0[0] + n0[1] * n0[1]) + (n0[2] * n0[2] + n0[3] * n0[3]) + (n1[0] * n1[0] + n1[1] * n1[1]) + (n1[2] * n1[2] + n1[3] * n1[3]); }
                ss += shx(ss, 16, fr + 16 * fq); ss += shx(ss, 32, fr + 16 * fq); ssv[m] = ss; }
            { const float v = fq == 0 ? ssv[0] : fq == 1 ? ssv[1] : fq == 2 ? ssv[2] : ssv[3];
              SSQ[((size_t)u.pn * SSQ_ROWS + (size_t)(u.pm * BM + wr * 64 + ai * HALF + fr + 16 * fq)) * 4 + wc] = v; } }
    }
};

template <class Epi, class Sched, bool ALIGN_EPI = false, bool SP2 = false>
__device__ __forceinline__ void gemm_phase(PG8_LAS unsigned char* lds, const Gemm g, const Sched& S, const Epi& E, int tid_in) {
    int tid_o = tid_in; asm volatile("" : "+v"(tid_o));
    const int tid = tid_o, wid = __builtin_amdgcn_readfirstlane(tid >> 6), lane = tid & 63, wr = wid >> 2, wc = wid & 3, fr = lane & 15, fq = lane >> 4;
    const int K = g.K, nt = K / BK;
    unsigned voffA[2], voffB[2];
#pragma unroll
    for (int i = 0; i < 2; ++i) { int R, C; stage_rc(tid * 16 + i * 8192, R, C); const int Rb = Epi::PERM ? ((R & ~31) + perm32(R & 31)) : R;
        voffA[i] = (unsigned)(R * g.lda + C) * 2u; voffB[i] = (unsigned)(Rb * K + C) * 2u; }
    const size_t kstep = (size_t)(BK * 2);
    const size_t hstep = (size_t)HALF * K * 2, hstepA = (size_t)HALF * g.lda * 2;
    const size_t tstep = 2 * hstep, tstepA = 2 * hstepA;
    const unsigned ldsw = (unsigned)wid * 1024u;
    const int aoff = lds_byte(wr * 64 + fr, fq * 8), boff = lds_byte(wc * 32 + fr, fq * 8);
#define PG8_SA(b, h) (((b) * 2 + (h)) * HTB)
#define PG8_SB(b, h) ((4 + (b) * 2 + (h)) * HTB)
#define PG8_STAGE(bufoff, gbase, voff) do { _Pragma("unroll") for (int _i = 0; _i < 2; ++_i) \
        __builtin_amdgcn_global_load_lds((const unsigned*)((const char*)(gbase) + (voff)[_i]), (PG8_LAS unsigned*)(lds + (bufoff) + ldsw + _i * 8192), 16, 0, 0); } while (0)
#define PG8_LDA(dst, b, h) do { _Pragma("unroll") for (int m = 0; m < 4; ++m) _Pragma("unroll") for (int k = 0; k < 2; ++k) dst[m][k] = *(const PG8_LAS bf16x8*)(lds + PG8_SA(b, h) + aoff + m * 2048 + k * 1024); } while (0)
#define PG8_LDB(dst, b, h) do { _Pragma("unroll") for (int n = 0; n < 2; ++n) _Pragma("unroll") for (int k = 0; k < 2; ++k) dst[n][k] = *(const PG8_LAS bf16x8*)(lds + PG8_SB(b, h) + boff + n * 2048 + k * 1024); } while (0)
#define PG8_MMA(ai, bj, At, Bt) do { __builtin_amdgcn_s_setprio(1); _Pragma("unroll") for (int m = 0; m < 4; ++m) _Pragma("unroll") for (int n = 0; n < 2; ++n) _Pragma("unroll") for (int k = 0; k < 2; ++k) \
        acc[ai][bj][m][n] = __builtin_amdgcn_mfma_f32_16x16x32_bf16(Bt[n][k], At[m][k], acc[ai][bj][m][n], 0, 0, 0); __builtin_amdgcn_s_setprio(0); } while (0)
#define PG8_WAIT_V(n) asm volatile("s_waitcnt vmcnt(" #n ")" ::: "memory")
#define PG8_WAIT_L(n) asm volatile("s_waitcnt lgkmcnt(" #n ")" ::: "memory")
#define PG8_BAR __builtin_amdgcn_s_barrier()
#define PG8_SCHED __builtin_amdgcn_sched_barrier(0)
    Unit cur, nxt; int ui = 0;
    if (!S.next(0, cur)) return;
    f32x4 acc[2][2][4][2];
#pragma unroll
    for (int a = 0; a < 2; ++a)
#pragma unroll
        for (int b = 0; b < 2; ++b)
#pragma unroll
            for (int m = 0; m < 4; ++m)
#pragma unroll
                for (int n = 0; n < 2; ++n) acc[a][b][m][n] = (f32x4){0.f, 0.f, 0.f, 0.f};
    bf16x8 At[4][2], B0[2][2], B1[2][2];
    const char* cA = (const char*)g.A + (size_t)cur.pm * tstepA; const char* cB = (const char*)g.Bt + (size_t)cur.pn * tstep;
    S.a_ready(cur);
    if constexpr (SP2) {
        PG8_STAGE(PG8_SB(0, 0), cB, voffB); PG8_STAGE(PG8_SB(0, 1), cB + hstep, voffB); PG8_STAGE(PG8_SA(0, 0), cA, voffA); PG8_STAGE(PG8_SA(0, 1), cA + hstepA, voffA);
        PG8_STAGE(PG8_SB(1, 0), cB + kstep, voffB); PG8_STAGE(PG8_SA(1, 0), cA + kstep, voffA); PG8_STAGE(PG8_SB(1, 1), cB + hstep + kstep, voffB);
        PG8_SCHED; E.pre(tid); PG8_SCHED;
        if (wr == 1) PG8_BAR;
        PG8_WAIT_V(8); PG8_BAR;
        PG8_WAIT_V(6); PG8_BAR;
    } else {
        PG8_STAGE(PG8_SB(0, 0), cB, voffB); PG8_STAGE(PG8_SA(0, 0), cA, voffA); PG8_STAGE(PG8_SB(0, 1), cB + hstep, voffB); PG8_STAGE(PG8_SA(0, 1), cA + hstepA, voffA);
        if (wr == 1) PG8_BAR;
        PG8_WAIT_V(4); PG8_BAR;
        PG8_STAGE(PG8_SB(1, 0), cB + kstep, voffB); PG8_STAGE(PG8_SA(1, 0), cA + kstep, voffA); PG8_STAGE(PG8_SB(1, 1), cB + hstep + kstep, voffB);
        PG8_WAIT_V(6); PG8_BAR;
    }
    for (;;) {
        const bool has_next = S.next(ui + 1, nxt);
        const char* nA = has_next ? (const char*)g.A + (size_t)nxt.pm * tstepA : cA; const char* nB = has_next ? (const char*)g.Bt + (size_t)nxt.pn * tstep : cB;
        for (int t = 0; t < nt; t += 2) {
            const bool last = (t == nt - 2);
            const char* a1 = cA + (size_t)(t + 1) * kstep;
            const char* a2 = last ? nA : cA + (size_t)(t + 2) * kstep; const char* b2 = last ? nB : cB + (size_t)(t + 2) * kstep;
            const char* a3 = a2 + kstep; const char* b3 = b2 + kstep;
            if (last && has_next) S.a_ready(nxt);
            if constexpr (SP2) {
            PG8_LDB(B0, 0, 0); PG8_LDB(B1, 0, 1); PG8_SCHED; PG8_LDA(At, 0, 0); PG8_STAGE(PG8_SA(1, 1), a1 + hstepA, voffA);
            PG8_WAIT_V(8); PG8_WAIT_L(0); PG8_BAR; PG8_MMA(0, 0, At, B0); PG8_MMA(0, 1, At, B1); PG8_BAR; PG8_SCHED;
            PG8_LDA(At, 0, 1); PG8_STAGE(PG8_SB(0, 0), b2, voffB); PG8_STAGE(PG8_SB(0, 1), b2 + hstep, voffB); PG8_STAGE(PG8_SA(0, 0), a2, voffA);
            PG8_WAIT_V(8); PG8_WAIT_L(0); PG8_BAR; PG8_MMA(1, 0, At, B0); PG8_MMA(1, 1, At, B1); PG8_BAR; PG8_SCHED;
            PG8_LDB(B0, 1, 0); PG8_LDB(B1, 1, 1); PG8_SCHED; PG8_LDA(At, 1, 0); PG8_STAGE(PG8_SA(0, 1), a2 + hstepA, voffA);
            PG8_WAIT_V(8); PG8_WAIT_L(0); PG8_BAR; PG8_MMA(0, 0, At, B0); PG8_MMA(0, 1, At, B1); PG8_BAR; PG8_SCHED;
            PG8_LDA(At, 1, 1); PG8_STAGE(PG8_SB(1, 0), b3, voffB); PG8_STAGE(PG8_SB(1, 1), b3 + hstep, voffB); PG8_STAGE(PG8_SA(1, 0), a3, voffA);
            PG8_WAIT_V(8); PG8_WAIT_L(0); PG8_BAR; PG8_MMA(1, 0, At, B0); PG8_MMA(1, 1, At, B1); PG8_BAR; PG8_SCHED;
            } else {
            PG8_LDB(B0, 0, 0); PG8_SCHED; PG8_LDA(At, 0, 0); PG8_STAGE(PG8_SA(1, 1), a1 + hstepA, voffA);
            PG8_WAIT_L(8); PG8_BAR; PG8_WAIT_L(0); PG8_MMA(0, 0, At, B0); PG8_BAR; PG8_SCHED;
            PG8_LDB(B1, 0, 1); PG8_STAGE(PG8_SB(0, 0), b2, voffB);
            PG8_BAR; PG8_WAIT_L(0); PG8_MMA(0, 1, At, B1); PG8_BAR;
            PG8_LDA(At, 0, 1); PG8_STAGE(PG8_SA(0, 0), a2, voffA);
            PG8_BAR; PG8_WAIT_L(0); PG8_MMA(1, 0, At, B0); PG8_BAR; PG8_SCHED;
            PG8_STAGE(PG8_SB(0, 1), b2 + hstep, voffB);
            PG8_WAIT_V(6); PG8_BAR; PG8_MMA(1, 1, At, B1); PG8_BAR;
            PG8_LDB(B0, 1, 0); PG8_SCHED; PG8_LDA(At, 1, 0); PG8_STAGE(PG8_SA(0, 1), a2 + hstepA, voffA);
            PG8_WAIT_L(8); PG8_BAR; PG8_WAIT_L(0); PG8_MMA(0, 0, At, B0); PG8_BAR; PG8_SCHED;
            PG8_LDB(B1, 1, 1); PG8_STAGE(PG8_SB(1, 0), b3, voffB);
            PG8_BAR; PG8_WAIT_L(0); PG8_MMA(0, 1, At, B1); PG8_BAR;
            PG8_LDA(At, 1, 1); PG8_STAGE(PG8_SA(1, 0), a3, voffA);
            PG8_BAR; PG8_WAIT_L(0); PG8_MMA(1, 0, At, B0); PG8_BAR; PG8_SCHED;
            PG8_STAGE(PG8_SB(1, 1), b3 + hstep, voffB);
            PG8_WAIT_V(6); PG8_BAR; PG8_MMA(1, 1, At, B1); PG8_BAR;
            }
        }
        if constexpr (ALIGN_EPI) { if (wr == 0) PG8_BAR; }
        if constexpr (!Epi::AFTER_DRAIN) { E(acc, cur, wr, wc, fr, fq); S.done(cur); }
        if (!has_next) break;
#pragma unroll
        for (int a = 0; a < 2; ++a)
#pragma unroll
            for (int b = 0; b < 2; ++b)
#pragma unroll
                for (int m = 0; m < 4; ++m)
#pragma unroll
                    for (int n = 0; n < 2; ++n) acc[a][b][m][n] = (f32x4){0.f, 0.f, 0.f, 0.f};
        cur = nxt; cA = nA; cB = nB; ++ui;
        if constexpr (ALIGN_EPI) { if (wr == 1) PG8_BAR; }
    }
    PG8_WAIT_V(0);
    if constexpr (!ALIGN_EPI) { if (wr == 0) PG8_BAR; }
    PG8_BAR;
    if constexpr (Epi::AFTER_DRAIN) { E.fused(acc, cur, wr, wc, fr, fq, lds, wid, lane); S.done(cur); }
#undef PG8_SA
#undef PG8_SB
#undef PG8_STAGE
#undef PG8_LDA
#undef PG8_LDB
#undef PG8_MMA
#undef PG8_WAIT_V
#undef PG8_WAIT_L
#undef PG8_BAR
#undef PG8_SCHED
}
}
namespace swa {
using bf16 = __hip_bfloat16;
typedef short bf16x8 __attribute__((ext_vector_type(8)));
typedef short s16x4 __attribute__((ext_vector_type(4)));
typedef float f32x16 __attribute__((ext_vector_type(16)));
typedef float f32x4 __attribute__((ext_vector_type(4)));
typedef unsigned u32x4 __attribute__((ext_vector_type(4)));
constexpr int D = 128;
constexpr float SCALE = 0.08838834764831845f;
constexpr float THR = 8.f;
constexpr int NW = 8, QBLK = 32, KVBLK = 64, QB = NW * QBLK;
constexpr int SHM_V = KVBLK * D * 2, SHM_K = KVBLK * D * 2;
constexpr int NS = 4, LDS_BYTES = NS * (SHM_V + SHM_K);

#define KSWZ(row, colB) ((row) * 256 + ((colB) ^ (((row) & 7) << 4)))
#define SBAR() __builtin_amdgcn_sched_barrier(0)
__device__ __forceinline__ int v_st(int k, int c) { const int kk = (k & ~0xC) | ((k & 4) << 1) | ((k & 8) >> 1); return ((kk >> 3) * 4 + (c >> 5)) * 512 + ((kk & 7) * 32 + (c & 31)) * 2; }
__device__ __forceinline__ int v_rd_base(int lane) { return ((lane & 3) << 3) | (((lane >> 2) & 3) << 6) | (((lane >> 4) & 1) << 5) | (((lane >> 5) & 1) << 8); }
constexpr int v_rd_off(int d0, int ks, int half) { return d0 * 512 + ks * 4096 + half * 2048; }
__device__ __forceinline__ int crow(int r, int hi) { return (r & 3) + 8 * (r >> 2) + 4 * hi; }
__device__ __forceinline__ unsigned cvtpk(float lo, float hi) { unsigned r; asm volatile("v_cvt_pk_bf16_f32 %0, %1, %2" : "=v"(r) : "v"(lo), "v"(hi)); return r; }
__device__ __forceinline__ bf16x8 load8(const bf16* p) { return *reinterpret_cast<const bf16x8*>(p); }
__device__ __forceinline__ void mask_tile(f32x16& p0, f32x16& p1, int dq, unsigned W) {
    const float NEG = -__builtin_inff();
#pragma unroll
    for (int r = 0; r < 16; ++r) {
        const int c = (r & 3) + 8 * (r >> 2);
        if ((unsigned)(dq - c) >= W) p0[r] = NEG;
        if ((unsigned)(dq - c - 32) >= W) p1[r] = NEG;
    }
}
__device__ __forceinline__ void partialSM(f32x16& p0, f32x16& p1, float& m_reg, float& mn, float& alpha) {
    float pmax = p0[0]; for (int r = 1; r < 16; ++r) pmax = fmaxf(pmax, p0[r]); for (int r = 0; r < 16; ++r) pmax = fmaxf(pmax, p1[r]);
    { auto rr = __builtin_amdgcn_permlane32_swap(__float_as_uint(pmax), __float_as_uint(pmax), false, false);
      pmax = fmaxf(__uint_as_float(rr[0]), __uint_as_float(rr[1])); }
    constexpr float C2 = 1.4426950408889634f * SCALE;
    if (__builtin_expect(__all((pmax - m_reg) * SCALE <= THR), 1)) { mn = m_reg; alpha = 1.f; }
    else { mn = fmaxf(m_reg, pmax); alpha = __builtin_amdgcn_exp2f((m_reg - mn) * C2); m_reg = mn; }
    const float mnL = -mn * C2;
    for (int r = 0; r < 16; ++r) p0[r] = fmaf(p0[r], C2, mnL); for (int r = 0; r < 16; ++r) p1[r] = fmaf(p1[r], C2, mnL);
    for (int r = 0; r < 16; ++r) p0[r] = __builtin_amdgcn_exp2f(p0[r]);
}
__device__ __forceinline__ void finishSM(f32x16& p0, f32x16& p1, float alpha, float& l_reg, bf16x8& pa0, bf16x8& pa1, bf16x8& pa2, bf16x8& pa3) {
    for (int r = 0; r < 16; ++r) p1[r] = __builtin_amdgcn_exp2f(p1[r]);
    float ps = 0; for (int r = 0; r < 16; ++r) ps += p0[r]; for (int r = 0; r < 16; ++r) ps += p1[r];
    { auto rr = __builtin_amdgcn_permlane32_swap(__float_as_uint(ps), __float_as_uint(ps), false, false);
      ps = __uint_as_float(rr[0]) + __uint_as_float(rr[1]); }
    l_reg = l_reg * alpha + ps;
#define PK4(P, B_, OUT) do { unsigned a0 = cvtpk(P[B_+0], P[B_+1]), a1 = cvtpk(P[B_+2], P[B_+3]);                          \
        unsigned b0 = cvtpk(P[B_+4], P[B_+5]), b1 = cvtpk(P[B_+6], P[B_+7]);                                             \
        auto r0 = __builtin_amdgcn_permlane32_swap(a0, b0, false, false); auto r1 = __builtin_amdgcn_permlane32_swap(a1, b1, false, false); \
        u32x4 w = {r0[0], r1[0], r0[1], r1[1]}; OUT = *reinterpret_cast<bf16x8*>(&w); } while (0)
    PK4(p0, 0, pa0); PK4(p0, 8, pa1); PK4(p1, 0, pa2); PK4(p1, 8, pa3);
#undef PK4
}
template <int KB, bool SK>
__device__ __forceinline__ void qkt(f32x16& p0, f32x16& p1, const char* K_lds, int r32, int hi, const bf16x8* qr, bool act) {
    if (SK && !act) { const float NEG = -__builtin_inff();
#pragma unroll
        for (int r = 0; r < 16; ++r) { p0[r] = NEG; p1[r] = NEG; } return; }
    p0 = f32x16{}; p1 = f32x16{};
    const char* kb[4];
#pragma unroll
    for (int dd = 0; dd < 4; ++dd) kb[dd] = K_lds + KB * SHM_K + KSWZ(r32, (dd * 16 + hi * 8) * 2);
#pragma unroll
    for (int d0 = 0; d0 < 8; ++d0) { const char* a = kb[d0 & 3] + (d0 >> 2) * 128;
        bf16x8 b0 = *reinterpret_cast<const bf16x8*>(a);
        bf16x8 b1 = *reinterpret_cast<const bf16x8*>(a + 32 * 256);
        p0 = __builtin_amdgcn_mfma_f32_32x32x16_bf16(b0, qr[d0], p0, 0, 0, 0);
        p1 = __builtin_amdgcn_mfma_f32_32x32x16_bf16(b1, qr[d0], p1, 0, 0, 0); }
}
template <int VB, bool SK>
__device__ __forceinline__ void pv_tile(f32x16* o, int vb0, bf16x8 pa0, bf16x8 pa1, bf16x8 pa2, bf16x8 pa3, bool act) {
    if (SK && !act) return;
#define TRRD(dst, off) asm volatile("ds_read_b64_tr_b16 %0, %1 offset:%2" : "=&v"(dst) : "v"(vb0), "i"(off) : "memory")
#define PV_D0(d0) do { s16x4 l0, l1, l2, l3, h0, h1, h2, h3; constexpr int b_ = VB * SHM_V + v_rd_off(d0, 0, 0); \
        TRRD(l0, b_); TRRD(h0, b_ + 2048); TRRD(l1, b_ + 4096); TRRD(h1, b_ + 6144); TRRD(l2, b_ + 8192); TRRD(h2, b_ + 10240); TRRD(l3, b_ + 12288); TRRD(h3, b_ + 14336); \
        asm volatile("s_waitcnt lgkmcnt(0)" ::: "memory"); SBAR();   \
        o[d0] = __builtin_amdgcn_mfma_f32_32x32x16_bf16((bf16x8){l0[0], l0[1], l0[2], l0[3], h0[0], h0[1], h0[2], h0[3]}, pa0, o[d0], 0, 0, 0);   \
        o[d0] = __builtin_amdgcn_mfma_f32_32x32x16_bf16((bf16x8){l1[0], l1[1], l1[2], l1[3], h1[0], h1[1], h1[2], h1[3]}, pa1, o[d0], 0, 0, 0);   \
        o[d0] = __builtin_amdgcn_mfma_f32_32x32x16_bf16((bf16x8){l2[0], l2[1], l2[2], l2[3], h2[0], h2[1], h2[2], h2[3]}, pa2, o[d0], 0, 0, 0);   \
        o[d0] = __builtin_amdgcn_mfma_f32_32x32x16_bf16((bf16x8){l3[0], l3[1], l3[2], l3[3], h3[0], h3[1], h3[2], h3[3]}, pa3, o[d0], 0, 0, 0); } while (0)
    PV_D0(0); PV_D0(1); PV_D0(2); PV_D0(3);
#undef PV_D0
#undef TRRD
}

struct BlockRef { const bf16* Q; const bf16* K; const bf16* V; bf16* O; float* L; int P0, skv, qs, kvs, os, ls, span, wpb, qsub, osub, lsub; };
struct Seam { bf16x8 qr[8]; int g, ri, rd; };
__device__ __forceinline__ int swa_jlo(int P0, int W) { const int lowk = P0 - W + 1; return lowk > 0 ? lowk / KVBLK : 0; }
#define VMW() asm volatile("s_waitcnt vmcnt(0)" ::: "memory")
#define VMWN(n) asm volatile("s_waitcnt vmcnt(%0)" :: "i"(n) : "memory")
#define LGW() asm volatile("s_waitcnt lgkmcnt(0)" ::: "memory")
typedef __attribute__((address_space(3))) unsigned char lds_u8;
struct DmaLane { unsigned kr0, kc0, kr1, kc1, vr0, vc0, vr1, vc1; };
__device__ __forceinline__ DmaLane dma_lane(int wid, int lane) {
    DmaLane d; const unsigned L = (unsigned)lane;
    d.kr0 = 8u * wid + (L >> 4); d.kr1 = d.kr0 + 4u; d.kc0 = ((L & 15u) ^ (d.kr0 & 7u)) * 16u; d.kc1 = ((L & 15u) ^ (d.kr1 & 7u)) * 16u;
    const unsigned s0 = 4u * wid + (L >> 5), s1 = s0 + 2u;
    const unsigned k0 = ((s0 >> 2) << 3) | ((L >> 2) & 7u), k1 = ((s1 >> 2) << 3) | ((L >> 2) & 7u);
    d.vr0 = (k0 & ~0xCu) | ((k0 & 4u) << 1) | ((k0 & 8u) >> 1); d.vr1 = (k1 & ~0xCu) | ((k1 & 4u) << 1) | ((k1 & 8u) >> 1);
    d.vc0 = ((s0 & 3u) * 32u + (L & 3u) * 8u) * 2u; d.vc1 = ((s1 & 3u) * 32u + (L & 3u) * 8u) * 2u;
    return d;
}
#define DMA16(gp, lp) __builtin_amdgcn_global_load_lds((const unsigned*)(gp), (__attribute__((address_space(3))) unsigned*)(lp), 16, 0, 0)
#define TILE_DMA(Kp, Vp, k0, st, slot) do { const unsigned st2_ = (unsigned)(st) * 2u, t0_ = (unsigned)(k0) * st2_;                                         \
        const char* kg_ = (const char*)(Kp) + t0_; const char* vg_ = (const char*)(Vp) + t0_;                                                                            \
        lds_u8* kl_ = ldsl + 4 * SHM_V + (slot) * SHM_K + wid * 2048; lds_u8* vl_ = ldsl + (slot) * SHM_V + wid * 2048;                                                 \
        DMA16(kg_ + (dl.kr0 * st2_ + dl.kc0), kl_); DMA16(kg_ + (dl.kr1 * st2_ + dl.kc1), kl_ + 1024);                                                                   \
        DMA16(vg_ + (dl.vr0 * st2_ + dl.vc0), vl_); DMA16(vg_ + (dl.vr1 * st2_ + dl.vc1), vl_ + 1024); } while (0)
#define QLOAD(R_) do { const int sub_ = wid / (R_).wpb, wq_ = wid - sub_ * (R_).wpb; const unsigned qo_ = (unsigned)(sub_ * (R_).qsub + (wq_ * QBLK + r32) * (R_).qs + hi * 8) * 2u;   \
        _Pragma("unroll") for (int d0 = 0; d0 < 8; ++d0) S.qr[d0] = *(const bf16x8*)((const char*)(R_).Q + qo_ + d0 * 32); } while (0)
__device__ __forceinline__ int swa_nt(const BlockRef& R, int W, int& j_lo) { j_lo = swa_jlo(R.P0, W); int j_hi = (R.P0 + R.span - 1) / KVBLK + 1; if (j_hi > R.skv / KVBLK) j_hi = R.skv / KVBLK;
    if (j_hi < j_lo + 2) j_hi = j_lo + 2; return j_hi - j_lo; }
__device__ __forceinline__ void causal_swa_prime(const BlockRef& cur, int W, char* lds, lds_u8* ldsl, Seam& S, int wave_s  ) {
    int tid_o = wave_s * 64 + lane_id_v(); asm volatile("" : "+v"(tid_o));
    const int tid = tid_o, wid = __builtin_amdgcn_readfirstlane(tid >> 6), lane = tid & 63, r32 = lane & 31, hi = lane >> 5;
    const DmaLane dl = dma_lane(wid, lane);
    const int kb0 = swa_jlo(cur.P0, W) * KVBLK;
    TILE_DMA(cur.K, cur.V, kb0, cur.kvs, 0); TILE_DMA(cur.K, cur.V, kb0 + KVBLK, cur.kvs, 1);
    QLOAD(cur); S.g = 0; S.ri = 2; S.rd = 0;
    VMW(); __builtin_amdgcn_s_barrier();
}
template <bool SK>
__device__ __forceinline__ void causal_swa_block(const BlockRef& cur, const BlockRef& nxt, int W, char* lds, lds_u8* ldsl, Seam& S, int wave_s  ) {
    int tid_o = wave_s * 64 + lane_id_v(); asm volatile("" : "+v"(tid_o));
    const int tid = tid_o, wid = __builtin_amdgcn_readfirstlane(tid >> 6), lane = tid & 63, r32 = lane & 31, hi = lane >> 5;
    int j_lo, jn_lo; const int NT = swa_nt(cur, W, j_lo), NTn = swa_nt(nxt, W, jn_lo);
    const bool same_ = nxt.K == cur.K && nxt.V == cur.V && nxt.kvs == cur.kvs && jn_lo >= j_lo; int ov = same_ ? j_lo + NT - jn_lo : 0; if (ov < 0) ov = 0; if (ov > NTn) ov = NTn;
    const int sub = wid / cur.wpb, wq = wid - sub * cur.wpb;
    const int qlo = cur.P0 + wq * QBLK, qm = qlo + r32 - 4 * hi;
    char* V_lds = lds; char* K_lds = lds + 4 * SHM_V;
    float m_reg = -1e30f, l_reg = 0; f32x16 o[4] = {};
    const int vb0 = (int)(uintptr_t)V_lds + v_rd_base(lane);
    const int g = __builtin_amdgcn_readfirstlane(S.g), gn = g + NT - ov; int ri = __builtin_amdgcn_readfirstlane(S.ri); const int rd = __builtin_amdgcn_readfirstlane(S.rd);
#define RESC(a) do { if (__any((a) < 1.f)) { for (int d_ = 0; d_ < 4; ++d_) for (int r = 0; r < 16; ++r) o[d_][r] *= (a); } } while (0)
#define KBASE(t) ((j_lo + (t)) * KVBLK)
#define ACT(t) (KBASE(t) <= qlo + QBLK - 1 && KBASE(t) + KVBLK - 1 >= qlo - W + 1)
#define MASKT(P0_, P1_, t) do { const int kb_ = KBASE(t); if ((!SK || ACT(t)) && (kb_ + KVBLK - 1 > qlo || kb_ <= qlo + QBLK - 1 - W)) mask_tile(P0_, P1_, qm - kb_, (unsigned)W); } while (0)
#define SLOT(t) ((g + (t)) & 3)
#define ISSUE(f) do { const int f_ = (f), p_ = g + f_; const bool own_ = f_ < NT; const int in_ = p_ - gn;                                                                       \
        if (p_ >= ri && (own_ || in_ < NTn)) { int l_ = lane; asm volatile("" : "+v"(l_)); const DmaLane dl = dma_lane(wid, l_);     \
            const bf16* Kp_ = own_ ? cur.K : nxt.K; const bf16* Vp_ = own_ ? cur.V : nxt.V; const int st_ = own_ ? cur.kvs : nxt.kvs;                                              \
            const int k0_ = own_ ? KBASE(f_) : (jn_lo + in_) * KVBLK; TILE_DMA(Kp_, Vp_, k0_, st_, p_ & 3); ri = p_ + 1; } } while (0)
#define STEP_END_T(t) do { if (g + (t) + 1 < rd) VMWN(16); else if (ri > g + (t) + 2) VMWN(4); else VMW(); LGW(); __builtin_amdgcn_s_barrier(); SBAR(); } while (0)
#define STEP_END() do { VMWN(4); LGW(); __builtin_amdgcn_s_barrier(); SBAR(); } while (0)
    f32x16 pA0, pA1, pB0, pB1; float mnA, mnB, alA, alB; bf16x8 pa0, pa1, pa2, pa3;
    ISSUE(2); SBAR();
    qkt<0, SK>(pA0, pA1, K_lds + SLOT(0) * SHM_K, r32, hi, S.qr, ACT(0));
    MASKT(pA0, pA1, 0); partialSM(pA0, pA1, m_reg, mnA, alA);
    STEP_END_T(0);
#define STEP(PX0, PX1, mnX, alX, PY0, PY1, alY, t) do {                                                                      \
        ISSUE((t) + 2); SBAR(); qkt<0, SK>(PX0, PX1, K_lds + SLOT(t) * SHM_K, r32, hi, S.qr, ACT(t));                        \
        finishSM(PY0, PY1, alY, l_reg, pa0, pa1, pa2, pa3); SBAR();                                                           \
        pv_tile<0, SK>(o, vb0 + SLOT((t) - 1) * SHM_V, pa0, pa1, pa2, pa3, ACT((t) - 1)); MASKT(PX0, PX1, (t)); partialSM(PX0, PX1, m_reg, mnX, alX);   \
        RESC(alX); STEP_END_T(t); } while (0)
    for (int t = 1; t + 1 < NT; t += 2) {
        STEP(pB0, pB1, mnB, alB, pA0, pA1, alA, t);
        STEP(pA0, pA1, mnA, alA, pB0, pB1, alB, t + 1);
    }
    const bool even = (NT & 1) == 0;
    if (even) STEP(pB0, pB1, mnB, alB, pA0, pA1, alA, NT - 1);
    const int rd_next = ri;
    QLOAD(nxt); SBAR();
    if (even) { finishSM(pB0, pB1, alB, l_reg, pa0, pa1, pa2, pa3); SBAR(); pv_tile<0, SK>(o, vb0 + SLOT(NT - 1) * SHM_V, pa0, pa1, pa2, pa3, ACT(NT - 1)); }
    else      { finishSM(pA0, pA1, alA, l_reg, pa0, pa1, pa2, pa3); SBAR(); pv_tile<0, SK>(o, vb0 + SLOT(NT - 1) * SHM_V, pa0, pa1, pa2, pa3, ACT(NT - 1)); }
    SBAR();
    { const float rl_ = __builtin_amdgcn_rcpf(l_reg);
      char* Ow = (char*)cur.O + ((size_t)sub * cur.osub + (size_t)(wq * QBLK) * cur.os) * 2; const unsigned oo_ = (unsigned)(r32 * cur.os + 8 * hi) * 2u;
#define PKO(P, B_, OUT) do { unsigned a0 = cvtpk(P[B_+0] * rl_, P[B_+1] * rl_), a1 = cvtpk(P[B_+2] * rl_, P[B_+3] * rl_);                          \
        unsigned b0 = cvtpk(P[B_+4] * rl_, P[B_+5] * rl_), b1 = cvtpk(P[B_+6] * rl_, P[B_+7] * rl_);                                             \
        auto r0 = __builtin_amdgcn_permlane32_swap(a0, b0, false, false); auto r1 = __builtin_amdgcn_permlane32_swap(a1, b1, false, false); \
        OUT = (u32x4){r0[0], r1[0], r0[1], r1[1]}; } while (0)
#pragma unroll
      for (int d0 = 0; d0 < 4; ++d0) { u32x4 w01, w23; PKO(o[d0], 0, w01); PKO(o[d0], 8, w23);
          *(u32x4*)(Ow + oo_ + d0 * 64) = w01; *(u32x4*)(Ow + oo_ + d0 * 64 + 32) = w23; }
#undef PKO
    }
    if (cur.L != nullptr && hi == 0) cur.L[(size_t)sub * cur.lsub + (size_t)(wq * QBLK + r32) * cur.ls] = m_reg * (1.4426950408889634f * SCALE) + __builtin_amdgcn_logf(l_reg);
    S.g = gn; S.ri = ri; S.rd = rd_next;
#undef RESC
#undef KBASE
#undef ACT
#undef MASKT
#undef SLOT
#undef ISSUE
#undef STEP_END
#undef STEP_END_T
#undef STEP
}
struct DRef { const bf16* Q; const bf16* K; const bf16* V; bf16* O; int P0; };
struct DSeam { bf16x8 qr[8]; int g; };
constexpr int D_K = 0, D_V = 2 * SHM_K, D_P = D_V + 4 * SHM_V, D_AL = D_P + 2 * 16384, D_LDS_BYTES = D_AL + 2 * 1024;
#define DU_K(Kp, k0, slot) do { int l_ = lane; asm volatile("" : "+v"(l_)); const unsigned L_ = (unsigned)l_; const char* kg_ = (const char*)(Kp) + (unsigned)(k0) * st2; lds_u8* kl_ = ldsl + D_K + (slot) * SHM_K + u4 * 4096;   \
        _Pragma("unroll") for (int i_ = 0; i_ < 4; ++i_) { const unsigned kr_ = 16u * u4 + 4u * i_ + (L_ >> 4); DMA16(kg_ + (kr_ * st2 + ((L_ & 15u) ^ (kr_ & 7u)) * 16u), kl_ + i_ * 1024); } } while (0)
#define DU_V(Vp, k0, slot) do { int l_ = lane; asm volatile("" : "+v"(l_)); const unsigned L_ = (unsigned)l_; const char* vg_ = (const char*)(Vp) + (unsigned)(k0) * st2 + (u4 >> 1) * 256;                                   \
        lds_u8* vl_ = ldsl + D_V + ((u4 >> 1) * 2 + (slot)) * SHM_V + (u4 & 1) * 1024;                                                                                                                     \
        _Pragma("unroll") for (int i_ = 0; i_ < 8; ++i_) { const unsigned s_ = 4u * i_ + 2u * (u4 & 1) + (L_ >> 5), kk_ = ((s_ >> 2) << 3) | ((L_ >> 2) & 7u), vr_ = (kk_ & ~0xCu) | ((kk_ & 4u) << 1) | ((kk_ & 8u) >> 1);   \
            DMA16(vg_ + (vr_ * st2 + ((s_ & 3u) * 32u + (L_ & 3u) * 8u) * 2u), vl_ + i_ * 2048); } } while (0)
#define DU_ISSUE_K(f) do { const int f_ = (f); const bool own_ = f_ < NT; DU_K(own_ ? cur.K : nxt.K, own_ ? 64 * f_ : 64 * (f_ - NT), (g + f_) & 1); } while (0)
#define DU_ISSUE_V(f) do { const int f_ = (f); const bool own_ = f_ < NT; DU_V(own_ ? cur.V : nxt.V, own_ ? 64 * f_ : 64 * (f_ - NT), (g + f_) & 1); } while (0)
#define D_QLOAD(R_) do { const unsigned qo_ = (unsigned)((wid * QBLK + r32) * qs + hi * 8) * 2u; _Pragma("unroll") for (int d0 = 0; d0 < 8; ++d0) S.qr[d0] = *(const bf16x8*)((const char*)(R_).Q + qo_ + d0 * 32); } while (0)
#define PKO2(P, B_, OUT) do { unsigned a0 = cvtpk(P[B_+0] * rl_, P[B_+1] * rl_), a1 = cvtpk(P[B_+2] * rl_, P[B_+3] * rl_);                          \
        unsigned b0 = cvtpk(P[B_+4] * rl_, P[B_+5] * rl_), b1 = cvtpk(P[B_+6] * rl_, P[B_+7] * rl_);                                             \
        auto r0 = __builtin_amdgcn_permlane32_swap(a0, b0, false, false); auto r1 = __builtin_amdgcn_permlane32_swap(a1, b1, false, false); \
        OUT = (u32x4){r0[0], r1[0], r0[1], r1[1]}; } while (0)
__device__ __forceinline__ void dattn_prime(const DRef& cur, int qs, int kvs, lds_u8* ldsl, DSeam& S, int wave_s) {
    int tid_o = wave_s * 64 + lane_id_v(); const int tid = tid_o, wid = __builtin_amdgcn_readfirstlane(tid >> 6), lane = tid & 63, r32 = lane & 31, hi = lane >> 5;
    if (wid < 4) { D_QLOAD(cur); }
    else { const unsigned u4 = (unsigned)(wid - 4); const unsigned st2 = (unsigned)kvs * 2u; DU_K(cur.K, 0, 0); DU_V(cur.V, 0, 0); DU_V(cur.V, 64, 1); }
    S.g = 0; VMW(); __builtin_amdgcn_s_barrier();
}
__device__ __forceinline__ void dattn_block_lower(const DRef& cur, const DRef& nxt, int qs, char* lds, DSeam& S, int wave_s) {
    int tid_o = wave_s * 64 + lane_id_v(); const int tid = tid_o, wid = __builtin_amdgcn_readfirstlane(tid >> 6), lane = tid & 63, r32 = lane & 31, hi = lane >> 5;
    const int NT = cur.P0 / KVBLK + 2, wq = wid, qlo = cur.P0 + wq * QBLK, qm = qlo + r32 - 4 * hi, g = __builtin_amdgcn_readfirstlane(S.g);
    char* K_lds = lds + D_K; char* P_w = lds + D_P + wq * 4096 + lane * 16; float* al_w = (float*)(lds + D_AL) + wq * 64;
    float m_reg = -1e30f, l_reg = 0;
    for (int t = 0; t < NT; ++t) {
        f32x16 p0, p1; float mn, al; bf16x8 pa0, pa1, pa2, pa3; const int par = (g + t) & 1;
        qkt<0, false>(p0, p1, K_lds + par * SHM_K, r32, hi, S.qr, true);
        { const int kb_ = t * KVBLK; if (kb_ + KVBLK - 1 > qlo) mask_tile(p0, p1, qm - kb_, 0x7fffffffu); }
        partialSM(p0, p1, m_reg, mn, al); finishSM(p0, p1, al, l_reg, pa0, pa1, pa2, pa3);
        { char* pw_ = P_w + par * 16384; *(bf16x8*)(pw_) = pa0; *(bf16x8*)(pw_ + 1024) = pa1; *(bf16x8*)(pw_ + 2048) = pa2; *(bf16x8*)(pw_ + 3072) = pa3; }
        if (hi == 0) { al_w[par * 256 + r32] = al; al_w[par * 256 + 32 + r32] = l_reg; }
        LGW(); __builtin_amdgcn_s_barrier(); SBAR();
    }
    D_QLOAD(nxt);
    S.g = (g + NT) & 1;
}
__device__ __forceinline__ void dattn_block_upper(const DRef& cur, const DRef& nxt, int kvs, int os, char* lds, lds_u8* ldsl, DSeam& S, int wave_s) {
    int tid_o = wave_s * 64 + lane_id_v(); const int tid = tid_o, wid = __builtin_amdgcn_readfirstlane(tid >> 6), lane = tid & 63, r32 = lane & 31, hi = lane >> 5;
    const int NT = cur.P0 / KVBLK + 2, g = __builtin_amdgcn_readfirstlane(S.g); const unsigned u4 = (unsigned)(wid - 4), st2 = (unsigned)kvs * 2u;
    const int vb = (int)(uintptr_t)(lds + D_V) + (int)(u4 >> 1) * 2 * SHM_V + v_rd_base(lane);
    const char* P_l = lds + D_P + lane * 16; const float* al_l = (const float*)(lds + D_AL);
    f32x16 o[4][2] = {};
#define TRRD(dst, off) asm volatile("ds_read_b64_tr_b16 %0, %1 offset:%2" : "=&v"(dst) : "v"(vbs_), "i"(off) : "memory")
#define D_UP_DG(dg) do { s16x4 l0, l1, l2, l3, h0, h1, h2, h3; constexpr int b_ = 512 * (dg);                                                                                       \
        TRRD(l0, b_); TRRD(h0, b_ + 2048); TRRD(l1, b_ + 4096); TRRD(h1, b_ + 6144); TRRD(l2, b_ + 8192); TRRD(h2, b_ + 10240); TRRD(l3, b_ + 12288); TRRD(h3, b_ + 14336);      \
        asm volatile("s_waitcnt lgkmcnt(0)" ::: "memory"); SBAR();                                                                                                                  \
        _Pragma("unroll") for (int qt = 0; qt < 4; ++qt) {                                                                                                                          \
            o[qt][dg] = __builtin_amdgcn_mfma_f32_32x32x16_bf16((bf16x8){l0[0], l0[1], l0[2], l0[3], h0[0], h0[1], h0[2], h0[3]}, pa[qt][0], o[qt][dg], 0, 0, 0);                   \
            o[qt][dg] = __builtin_amdgcn_mfma_f32_32x32x16_bf16((bf16x8){l1[0], l1[1], l1[2], l1[3], h1[0], h1[1], h1[2], h1[3]}, pa[qt][1], o[qt][dg], 0, 0, 0);                   \
            o[qt][dg] = __builtin_amdgcn_mfma_f32_32x32x16_bf16((bf16x8){l2[0], l2[1], l2[2], l2[3], h2[0], h2[1], h2[2], h2[3]}, pa[qt][2], o[qt][dg], 0, 0, 0);                   \
            o[qt][dg] = __builtin_amdgcn_mfma_f32_32x32x16_bf16((bf16x8){l3[0], l3[1], l3[2], l3[3], h3[0], h3[1], h3[2], h3[3]}, pa[qt][3], o[qt][dg], 0, 0, 0); } } while (0)
#define D_UP_TILE(u) do { const int u_ = (u), par_ = (g + u_) & 1; const char* pr_ = P_l + par_ * 16384; bf16x8 pa[4][4];                                                           \
        _Pragma("unroll") for (int qt = 0; qt < 4; ++qt) { _Pragma("unroll") for (int k = 0; k < 4; ++k) pa[qt][k] = *(const bf16x8*)(pr_ + qt * 4096 + k * 1024);                  \
            const float al = al_l[par_ * 256 + qt * 64 + r32]; if (__any(al < 1.f)) { for (int r = 0; r < 16; ++r) { o[qt][0][r] *= al; o[qt][1][r] *= al; } } }                    \
        const int vbs_ = vb + par_ * SHM_V + (int)(u4 & 1) * 1024; SBAR(); D_UP_DG(0); D_UP_DG(1); SBAR();                                                                          \
        DU_ISSUE_V(u_ + 2); } while (0)
    for (int t = 0; t < NT; ++t) {
        DU_ISSUE_K(t + 1); SBAR();
        if (t > 0) { D_UP_TILE(t - 1); VMWN(8); }
        else VMW();
        LGW(); __builtin_amdgcn_s_barrier(); SBAR();
    }
    D_UP_TILE(NT - 1);
    { const int parl = (g + NT - 1) & 1; char* Ob = (char*)cur.O + (size_t)(64 * u4) * 2; const unsigned oo_ = (unsigned)(r32 * os + 8 * hi) * 2u;
#pragma unroll
      for (int qt = 0; qt < 4; ++qt) { const float rl_ = __builtin_amdgcn_rcpf(al_l[parl * 256 + qt * 64 + 32 + r32]); char* Ow = Ob + (size_t)(qt * QBLK) * os * 2;
#pragma unroll
          for (int dg = 0; dg < 2; ++dg) { u32x4 w01, w23; PKO2(o[qt][dg], 0, w01); PKO2(o[qt][dg], 8, w23);
              *(u32x4*)(Ow + oo_ + dg * 64) = w01; *(u32x4*)(Ow + oo_ + dg * 64 + 32) = w23; } } }
    S.g = (g + NT) & 1;
#undef D_UP_TILE
#undef D_UP_DG
#undef TRRD
}
#undef DU_K
#undef DU_V
#undef DU_ISSUE_K
#undef DU_ISSUE_V
#undef D_QLOAD
#undef PKO2
__device__ __forceinline__ void causal_swa_finish() { __builtin_amdgcn_s_setprio(0); VMW(); __builtin_amdgcn_s_barrier(); }
#undef VMW
#undef VMWN
#undef LGW
#undef DMA16
#undef TILE_DMA
#undef QLOAD
#undef KSWZ
#undef SBAR
}


constexpr int NWAVES = 8;
#ifndef MK_PER_PHASE
#define MK_PER_PHASE 0
#endif

constexpr int BATCH = 2, SEQ = 8192, DM = 2048, FF = 5632, PLE = 256, DEPTH = 4, HD = 128;
constexpr int M = BATCH * SEQ;
constexpr int NA = 5120, NB = 6144, NC = 6144;
constexpr int NQ = 6144;
constexpr float RMS_EPS = 1e-6f, SUBLN_EPS = 1e-5f;
constexpr int N_PHASES = 37;
#ifndef RES16_PAIRS
#define RES16_PAIRS 4
#endif

constexpr size_t MiB = 1u << 20;
constexpr size_t WS_CTL = 0, CTL_ZERO_BYTES = 1 * MiB;
constexpr size_t WS_SSQ0 = 1 * MiB, WS_SSQ1 = 3 * MiB;
constexpr size_t WS_LSE = 5 * MiB;
constexpr size_t WS_H16 = 8 * MiB;
constexpr size_t WS_HB0 = 136 * MiB, WS_HB1 = 200 * MiB;
constexpr size_t WS_BIG = 264 * MiB;
constexpr size_t WS_AO = 456 * MiB;
constexpr size_t WS_OT = 520 * MiB;
constexpr size_t WS_PB = 712 * MiB;
constexpr size_t WS_W = 744 * MiB;
constexpr size_t WL_FFN1_IN = 0, WL_FFN1_OUT = WL_FFN1_IN + (size_t)2 * FF * DM, WL_FFN2_IN = WL_FFN1_OUT + (size_t)DM * FF, WL_FFN2_OUT = WL_FFN2_IN + (size_t)2 * FF * DM,
                 WL_PLE_G = WL_FFN2_OUT + (size_t)DM * FF, WL_PLE_P = WL_PLE_G + (size_t)DM * DM, WL_MIX_IN = WL_PLE_P + (size_t)DM * PLE, WL_MIX_OUT = WL_MIX_IN + (size_t)6144 * DM,
                 WL_SIZE = WL_MIX_OUT + (size_t)DM * DM;
constexpr size_t WS_END = WS_W + (size_t)DEPTH * WL_SIZE * 2;
constexpr int CW_BAR = 4096;

constexpr int RING_OFF = 0, RING_BYTES = 131072;
constexpr int LDSCTL_OFF = 139264, MISC_OFF = LDSCTL_OFF + 320;
constexpr int RSTD_OFF = LDSCTL_OFF + 1024;
constexpr int LDS_BYTES = 147456;
static_assert(MISC_OFF + 128 <= RSTD_OFF && RSTD_OFF + 1024 <= LDS_BYTES, "LDS map");

#define GAS __attribute__((address_space(1)))
#define LAS __attribute__((address_space(3)))
typedef unsigned short bf16;
typedef unsigned v4u __attribute__((ext_vector_type(4)));
typedef float f32x4 __attribute__((ext_vector_type(4)));
typedef short bf16x8 __attribute__((ext_vector_type(8)));
typedef GAS unsigned gu32;
typedef GAS unsigned long long gu64;
#define RLX_AGENT __ATOMIC_RELAXED, __HIP_MEMORY_SCOPE_AGENT
#define LDS_WAIT() asm volatile("s_waitcnt lgkmcnt(0)" ::: "memory")
#define VM_WAIT() asm volatile("s_waitcnt vmcnt(0)" ::: "memory")
__device__ __forceinline__ unsigned long long rt() { return __builtin_amdgcn_s_memrealtime(); }
__device__ __forceinline__ unsigned f2bf(float f) { unsigned u = __builtin_bit_cast(unsigned, f); return (u + 0x7fffu + ((u >> 16) & 1u)) >> 16; }
__device__ __forceinline__ unsigned pk2(float lo, float hi) { return f2bf(lo) | (f2bf(hi) << 16); }

#define XB_TMO      128
#define XB_XCNT(j)  (256  + 64 * (j))
#define XB_XSUB(j)  (1280 + 64 * (j))
#define XB_XGEN(j)  (2304 + 64 * (j))
#define XB_TOP      3328
#define XB_TOPGEN   3392
#define XCD_BAR_WORDS 3456
#define XB_SPIN_CAP (1u << 18)

__device__ __forceinline__ unsigned xb_ld(unsigned* p)              { return __hip_atomic_load(p, __ATOMIC_RELAXED, __HIP_MEMORY_SCOPE_AGENT); }
__device__ __forceinline__ unsigned xb_add(unsigned* p, unsigned v) { return __hip_atomic_fetch_add(p, v, __ATOMIC_RELAXED, __HIP_MEMORY_SCOPE_AGENT); }
__device__ __forceinline__ unsigned xb_xcc_id() { return (unsigned)__builtin_amdgcn_s_getreg((3 << 11) | 20) & 0xFu; }
#define XB_SPIN(cond, bar) do { unsigned _sp = 0; while (cond) { __builtin_amdgcn_s_sleep(1); \
    if ((++_sp & 255u) == 0u) { if (xb_ld(&(bar)[XB_TMO])) break; if (_sp > XB_SPIN_CAP) { atomicAdd(&(bar)[XB_TMO], 1u); break; } } } } while (0)

struct XcdBarrier {
    unsigned* bar; unsigned x;
    volatile LAS unsigned* st;
};

__device__ __forceinline__ XcdBarrier xcd_barrier_post(unsigned* bar, volatile LAS unsigned* st, bool leader  ) {
    XcdBarrier b; b.bar = bar; b.x = xb_xcc_id(); b.st = st;
    if (leader) (void)xb_add(&bar[XB_XCNT(b.x)], 1u);
    return b;
}
__device__ __forceinline__ void xcd_barrier_complete(unsigned* bar, unsigned x, unsigned& nloc, unsigned& nx) {
    const unsigned G = gridDim.x * gridDim.y * gridDim.z;
    unsigned sum, cnt, mine, sp = 0u;
    for (;;) {
        sum = 0u; cnt = 0u; mine = 0u;
#pragma unroll
        for (unsigned j = 0; j < 16; ++j) { const unsigned c = xb_ld(&bar[XB_XCNT(j)]); sum += c; cnt += (c > 0u) ? 1u : 0u; mine = (j == x) ? c : mine; }
        if (sum == G) break;
        __builtin_amdgcn_s_sleep(1);
        if ((++sp & 255u) == 0u) { if (xb_ld(&bar[XB_TMO])) break; if (sp > XB_SPIN_CAP) { atomicAdd(&bar[XB_TMO], 1u); break; } }
    }
    nloc = mine > 0u ? mine : 1u; nx = cnt > 0u ? cnt : 1u;
}

__device__ __forceinline__ void xcd_barrier(const XcdBarrier& b, bool leader) {
    asm volatile("s_waitcnt vmcnt(0)" ::: "memory");
    __syncthreads();
    if (leader) {
        unsigned* bar = b.bar;
        __builtin_amdgcn_s_waitcnt(0);
        unsigned nloc = b.st[0], nx = b.st[1];
        if (nloc == 0u) { xcd_barrier_complete(bar, b.x, nloc, nx); b.st[0] = nloc; b.st[1] = nx; }
        const unsigned old = xb_add(&bar[XB_XSUB(b.x)], 1u);
        const unsigned gen = old / nloc;
        if (old + 1u == (gen + 1u) * nloc) {
            __builtin_amdgcn_fence(__ATOMIC_RELEASE, "agent");
            asm volatile("s_waitcnt vmcnt(0)" ::: "memory");
            const unsigned og = xb_add(&bar[XB_TOP], 1u);
            const unsigned tg = og / nx;
            if (og + 1u == (tg + 1u) * nx) xb_add(&bar[XB_TOPGEN], 1u);
            else XB_SPIN(xb_ld(&bar[XB_TOPGEN]) == tg, bar);
            __builtin_amdgcn_fence(__ATOMIC_ACQUIRE, "agent");
            xb_add(&bar[XB_XGEN(b.x)], 1u);
            asm volatile("s_waitcnt vmcnt(0)" ::: "memory");
        } else {
            XB_SPIN(xb_ld(&bar[XB_XGEN(b.x)]) == gen, bar);
            __builtin_amdgcn_fence(__ATOMIC_ACQUIRE, "agent");
            asm volatile("s_waitcnt vmcnt(0)" ::: "memory");
        }
    }
    __syncthreads();
}

typedef __hip_bfloat16 bf16h;
struct Args { const float* in[23]; float* out; unsigned char* ws; int ph_lo, ph_hi; };

__device__ __forceinline__ float wave_sum(float v, int lane) {
#pragma unroll
    for (int o = 1; o < 64; o <<= 1) v += shx(v, o, lane);
    return v;
}
__device__ __forceinline__ float bflo(unsigned w) { return __uint_as_float(w << 16); }
__device__ __forceinline__ float bfhi(unsigned w) { return __uint_as_float(w & 0xffff0000u); }
__device__ __forceinline__ unsigned pkh(float lo, float hi) { return pg8::cvt_pk_f16(lo, hi); }
__device__ __forceinline__ unsigned cvtpk2(float lo, float hi) { unsigned r; asm volatile("v_cvt_pk_bf16_f32 %0, %1, %2" : "=v"(r) : "v"(lo), "v"(hi)); return r; }

constexpr int CTX_OFF = LDSCTL_OFF + 2048;
__device__ __forceinline__ unsigned char* ctxp(LAS unsigned char* ldsl, int i) {
    const unsigned long long v = *(volatile LAS unsigned long long*)(ldsl + CTX_OFF + 8 * i);
    const unsigned long long u = ((unsigned long long)(unsigned)__builtin_amdgcn_readfirstlane((int)(v >> 32)) << 32) | (unsigned long long)(unsigned)__builtin_amdgcn_readfirstlane((int)(unsigned)v);
    return (unsigned char*)(GAS unsigned char*)u;
}
__device__ __forceinline__ int map_row(int n, int mode) {
    if (mode == 1) { const int half = n >= FF ? 1 : 0, j = n - half * FF; return (j >> 7) * 256 + half * 128 + (j & 127); }
    if (mode == 2) { if (n < DM) return 2 * DM + n; const int half = n >= 2 * DM ? 1 : 0, j = n - DM - half * DM; return (j >> 7) * 256 + half * 128 + (j & 127); }
    return n;
}
__device__ __forceinline__ void p0_transpose_item(const float* W, const float* gain, int K, int N, bf16* WT, int mode, LAS float* scr, int item, int lane) {
    const int nblk = N >> 6, kb = item / nblk, nb = item - kb * nblk, k0 = 64 * kb, n0 = 64 * nb, d0 = map_row(n0, mode);
    const int r4 = lane >> 4, cg = lane & 15;
    const GAS f32x4* src = (const GAS f32x4*)(W + (size_t)(k0 + r4) * N + n0) + cg;
    f32x4 v[16];
#pragma unroll
    for (int i = 0; i < 16; ++i) v[i] = src[(size_t)i * N];
    if (gain) {
#pragma unroll
        for (int i = 0; i < 16; ++i) v[i] = v[i] * gain[k0 + 4 * i + r4]; }
    LAS float* wp = scr + r4 * 65 + 4 * cg;
#pragma unroll
    for (int i = 0; i < 16; ++i) { wp[(4 * i) * 65 + 0] = v[i].x; wp[(4 * i) * 65 + 1] = v[i].y; wp[(4 * i) * 65 + 2] = v[i].z; wp[(4 * i) * 65 + 3] = v[i].w; }
    LDS_WAIT(); asm volatile("" ::: "memory");
    const int c = lane & 7;
#pragma unroll
    for (int j = 0; j < 8; ++j) { const int n = (lane >> 3) + 8 * j; const LAS float* s = scr + (8 * c) * 65 + n;
        v4u o; o.x = pk2(s[0 * 65], s[1 * 65]); o.y = pk2(s[2 * 65], s[3 * 65]); o.z = pk2(s[4 * 65], s[5 * 65]); o.w = pk2(s[6 * 65], s[7 * 65]);
        *(GAS v4u*)(WT + (size_t)(d0 + n) * K + k0 + 8 * c) = o; }
    LDS_WAIT(); asm volatile("" ::: "memory");
}
struct WJob { const float* W; const float* gain; bf16* dst; int K, N, mode; };
#define CTX_IN(i) ((const float*)ctxp(ldsl, (i)))
__device__ __forceinline__ WJob get_job(LAS unsigned char* ldsl, int j) {
    const int l = j >> 3, t = j & 7, kind = l % 3, jj = l / 3; bf16* wl = (bf16*)(ctxp(ldsl, 24) + WS_W) + (size_t)l * WL_SIZE; WJob r;
    if (t == 0)      { r.W = CTX_IN(3) + (size_t)l * DM * 2 * FF;  r.gain = CTX_IN(2) + l * DM;  r.dst = wl + WL_FFN1_IN;  r.K = DM;  r.N = 2 * FF; r.mode = 1; }
    else if (t == 1) { r.W = CTX_IN(4) + (size_t)l * FF * DM;      r.gain = nullptr;           r.dst = wl + WL_FFN1_OUT; r.K = FF;  r.N = DM;     r.mode = 0; }
    else if (t == 2) { r.W = CTX_IN(16) + (size_t)l * DM * 2 * FF; r.gain = CTX_IN(15) + l * DM; r.dst = wl + WL_FFN2_IN;  r.K = DM;  r.N = 2 * FF; r.mode = 1; }
    else if (t == 3) { r.W = CTX_IN(17) + (size_t)l * FF * DM;     r.gain = nullptr;           r.dst = wl + WL_FFN2_OUT; r.K = FF;  r.N = DM;     r.mode = 0; }
    else if (t == 4) { r.W = CTX_IN(19) + (size_t)l * DM * DM;     r.gain = CTX_IN(18) + l * DM; r.dst = wl + WL_PLE_G;    r.K = DM;  r.N = DM;     r.mode = 0; }
    else if (t == 5) { r.W = CTX_IN(21) + (size_t)l * PLE * DM;    r.gain = nullptr;           r.dst = wl + WL_PLE_P;    r.K = PLE; r.N = DM;     r.mode = 0; }
    else if (t == 6) { r.gain = CTX_IN(5) + l * DM; r.dst = wl + WL_MIX_IN; r.K = DM;
        if (kind == 0)      { r.W = CTX_IN(6) + (size_t)jj * DM * NA;  r.N = NA; r.mode = 0; }
        else if (kind == 1) { r.W = CTX_IN(8) + (size_t)jj * DM * NB;  r.N = NB; r.mode = 0; }
        else                { r.W = CTX_IN(12) + (size_t)jj * DM * NC; r.N = NC; r.mode = 2; } }
    else { r.gain = nullptr; r.dst = wl + WL_MIX_OUT; r.K = DM; r.N = DM; r.mode = 0;
        r.W = (kind == 0 ? CTX_IN(7) : (kind == 1 ? CTX_IN(9) : CTX_IN(14))) + (size_t)jj * DM * DM; }
    return r;
}
__device__ __forceinline__ void p0_prologue(LAS unsigned char* ldsl, int wave, int lane, int G) {
    LAS unsigned char* lds = ldsl; unsigned char* wsb = ctxp(ldsl, 24);
    LAS float* scr = (LAS float*)(lds + RING_OFF + wave * 16640);
    const int gw = (int)blockIdx.x * NWAVES + wave, NGW = G * NWAVES;
    long base = 0;
    for (int j = 0; j < 8 * DEPTH; ++j) {
        const WJob jb = get_job(ldsl, j); const int nitems = (jb.K / 64) * (jb.N / 64);
        int start = (int)(((long)gw - base) % NGW); if (start < 0) start += NGW;
        for (int it = start; it < nitems; it += NGW) p0_transpose_item(jb.W, jb.gain, jb.K, jb.N, jb.dst, jb.mode, scr, it, lane);
        base += nitems;
    }
    bf16* HB = (bf16*)(wsb + WS_HB0); bf16* LOB = (bf16*)(wsb + WS_H16); float* SSQ = (float*)(wsb + WS_SSQ0); const float* xin = CTX_IN(0);
    for (int m = gw; m < M; m += NGW) {
        const GAS f32x4* xr = (const GAS f32x4*)(xin + (size_t)m * DM) + lane;
        GAS unsigned long long* o8 = (GAS unsigned long long*)(HB + (size_t)m * DM) + lane; GAS unsigned long long* l8 = (GAS unsigned long long*)(LOB + (size_t)m * DM) + lane; float s = 0.f;
#pragma unroll
        for (int j = 0; j < 8; ++j) { const f32x4 v = xr[64 * j]; s += (v.x * v.x + v.y * v.y) + (v.z * v.z + v.w * v.w);
            const unsigned w0 = pk2(v.x, v.y), w1 = pk2(v.z, v.w); o8[64 * j] = (unsigned long long)w0 | ((unsigned long long)w1 << 32);
            l8[64 * j] = (unsigned long long)pkh(v.x, v.y) | ((unsigned long long)pkh(v.z, v.w) << 32); }
        s = wave_sum(s, lane);
        if (lane < 32) SSQ[((size_t)(lane >> 2) * M + m) * 4 + (lane & 3)] = lane == 0 ? s : 0.f;
    }
    { const GAS f32x4* p4 = (const GAS f32x4*)CTX_IN(1); GAS v4u* o = (GAS v4u*)(wsb + WS_PB); const long nch = (long)DEPTH * M * PLE / 8;
      for (long i = (long)gw * 64 + lane; i < nch; i += (long)NGW * 64) { const f32x4 v0 = p4[2 * i], v1 = p4[2 * i + 1]; v4u w; w.x = pk2(v0.x, v0.y); w.y = pk2(v0.z, v0.w); w.z = pk2(v1.x, v1.y); w.w = pk2(v1.z, v1.w); o[i] = w; } }
}

static_assert(pg8::SSQ_ROWS == M && pg8::SSQ_DM == DM && pg8::SSQ_EPS == RMS_EPS, "SSQ layout");

constexpr int CW_GRP = 16384;
__device__ __forceinline__ void group_barrier(gu32* ctl, int pm, unsigned target, volatile LAS unsigned* lflag, bool leader) {
    asm volatile("s_waitcnt vmcnt(0)" ::: "memory");
    __syncthreads();
    if (leader) {
        gu32* cnt = ctl + CW_GRP + 64 * pm; gu32* tmo = ctl + CW_BAR + XB_TMO;
        const unsigned st = lflag[0];
        if (st != 2u) { __builtin_amdgcn_fence(__ATOMIC_RELEASE, "agent"); asm volatile("s_waitcnt vmcnt(0)" ::: "memory"); }
        __hip_atomic_fetch_add(cnt, 1u, RLX_AGENT);
        unsigned sp = 0u;
        while (__hip_atomic_load(cnt, RLX_AGENT) < target) { __builtin_amdgcn_s_sleep(1);
            if ((++sp & 255u) == 0u) { if (__hip_atomic_load(tmo, RLX_AGENT)) break; if (sp > XB_SPIN_CAP) { __hip_atomic_fetch_add(tmo, 1u, RLX_AGENT); break; } } }
        __builtin_amdgcn_fence(__ATOMIC_ACQUIRE, "agent");
        asm volatile("s_waitcnt vmcnt(0)" ::: "memory");
        if (st == 0u) { const unsigned x0 = __hip_atomic_load(cnt + 8, RLX_AGENT), x1 = __hip_atomic_load(cnt + 9, RLX_AGENT), x2 = __hip_atomic_load(cnt + 10, RLX_AGENT), x3 = __hip_atomic_load(cnt + 11, RLX_AGENT);
            lflag[0] = (x0 != 0u && x0 == x1 && x0 == x2 && x0 == x3) ? 2u : 1u; }
    }
    __syncthreads();
}

__device__ __forceinline__ swa::BlockRef a_ref(int n, int c, const bf16h* QKV, bf16h* OT, float* LSE) {
    const int g = n >> 2, k = n & 3, dil = g == 0 ? 1 : (g == 1 ? 4 : 16), npb = 128 / dil;
    int idx = c * 4 + k; const int pb = idx % npb; idx /= npb; const int kvh = idx & 3; idx >>= 2; const int r = idx % dil, b = idx / dil;
    const size_t row0 = (size_t)b * SEQ + r, rowq = row0 + (size_t)dil * 64 * pb;
    swa::BlockRef R; R.Q = QKV + rowq * NQ + kvh * 4 * HD; R.K = QKV + row0 * NQ + DM + ((g * 2 + 0) * 4 + kvh) * HD; R.V = QKV + row0 * NQ + DM + ((g * 2 + 1) * 4 + kvh) * HD;
    R.O = OT + (size_t)g * M * DM + rowq * DM + kvh * 4 * HD; R.L = LSE + (size_t)g * M * 16 + rowq * 16 + kvh * 4; R.P0 = 64 * pb; R.skv = SEQ / dil; R.qs = dil * NQ; R.kvs = dil * NQ; R.os = dil * DM; R.ls = dil * 16;
    R.span = 64; R.wpb = 2; R.qsub = HD; R.osub = HD; R.lsub = 1;
    return R;
}
__device__ __forceinline__ swa::BlockRef b_ref(int n, int c, const bf16h* QKV, bf16h* OT) {
    const int x = c & 7, j = c >> 3, it = n >> 1, pass = n & 1, combo = x * 8 + 2 * it + (j >> 4), y = j & 15, qb = pass ? 31 - y : y;
    const int vhalf = combo & 1, cc = (combo >> 1) & 1, h = (combo >> 2) & 7, b = combo >> 5; const size_t row0 = (size_t)b * SEQ, rowq = row0 + 256 * qb;
    swa::BlockRef R; R.Q = QKV + rowq * NQ + h * 256 + cc * HD; R.K = QKV + row0 * NQ + DM + h * 256 + cc * HD; R.V = QKV + row0 * NQ + 2 * DM + h * 256 + vhalf * HD;
    R.O = OT + (size_t)cc * M * DM + rowq * DM + h * 256 + vhalf * HD; R.L = nullptr; R.P0 = 256 * qb; R.skv = SEQ; R.qs = NQ; R.kvs = NQ; R.os = DM; R.ls = 0; R.span = 256; R.wpb = 8; R.qsub = 0; R.osub = 0; R.lsub = 0;
    return R;
}

__device__ __forceinline__ swa::DRef bd_ref(int n, int c, const bf16h* QKV, bf16h* OT) {
    const int x = c & 7, j = c >> 3, prob = 4 * x + (n >> 1), cc = prob & 1, h = (prob >> 1) & 7, b = prob >> 4, qb = (n & 1) ? 63 - j : j;
    const unsigned row0 = (unsigned)(b * SEQ), rowq = row0 + (unsigned)(128 * qb);
    swa::DRef R; R.Q = QKV + (rowq * (unsigned)NQ + (unsigned)(h * 256 + cc * HD)); R.K = QKV + (row0 * (unsigned)NQ + (unsigned)(DM + h * 256 + cc * HD)); R.V = QKV + (row0 * (unsigned)NQ + (unsigned)(2 * DM + h * 256));
    R.O = OT + ((unsigned)cc * (unsigned)(M * DM) + rowq * (unsigned)DM + (unsigned)(h * 256)); R.P0 = 128 * qb;
    return R;
}
__device__ __forceinline__ void dattn_phase_lower(int cwg, const bf16h* BIG, bf16h* OT, char* ring, swa::lds_u8* ringl, int wave_s) {
    swa::DSeam S; swa::DRef cur = bd_ref(0, cwg, BIG, OT), nxt;
    swa::dattn_prime(cur, NQ, NQ, ringl, S, wave_s);
    for (int n = 0; n < 8; ++n) { nxt = (n < 7) ? bd_ref(n + 1, cwg, BIG, OT) : cur; swa::dattn_block_lower(cur, nxt, NQ, ring, S, wave_s); cur = nxt; }
}
__device__ __forceinline__ void dattn_phase_upper(int cwg, const bf16h* BIG, bf16h* OT, char* ring, swa::lds_u8* ringl, int wave_s) {
    swa::DSeam S; swa::DRef cur = bd_ref(0, cwg, BIG, OT), nxt;
    swa::dattn_prime(cur, NQ, NQ, ringl, S, wave_s);
    for (int n = 0; n < 8; ++n) { nxt = (n < 7) ? bd_ref(n + 1, cwg, BIG, OT) : cur; swa::dattn_block_upper(cur, nxt, NQ, DM, ring, ringl, S, wave_s); cur = nxt; }
}
static_assert(swa::D_LDS_BYTES <= LDSCTL_OFF, "differential-attention LDS map");

__global__ void __launch_bounds__(NWAVES * 64, 2) mk_fwd(Args args) {
    extern __shared__ __attribute__((aligned(16))) unsigned char lds[];
    LAS unsigned char* ldsl = (LAS unsigned char*)lds;
    volatile LAS unsigned* MISC = (volatile LAS unsigned*)(ldsl + MISC_OFF);
    LAS float* rstab = (LAS float*)(ldsl + RSTD_OFF);
    const int wave_s = __builtin_amdgcn_readfirstlane((int)threadIdx.x >> 6);
    const int tid0 = wave_s * 64 + lane_id_v();
#define LEADER() (wave_s == 0 && lane_id_v() == 0)
#define PHASE_IDS() int tid = wave_s * 64 + lane_id_v(), cwg = blockIdx.x; asm volatile("" : "+v"(tid), "+s"(cwg)); const int lane = tid & 63, wave = __builtin_amdgcn_readfirstlane(tid >> 6), G = gridDim.x, \
        gw = cwg * NWAVES + wave, NGW = G * NWAVES, my_pm = (cwg & 7) * 8 + ((cwg >> 3) & 7); (void)lane; (void)gw; (void)NGW; (void)my_pm
    for (int u = tid0; u < (LDS_BYTES - LDSCTL_OFF) / 4; u += NWAVES * 64) ((LAS unsigned*)(ldsl + LDSCTL_OFF))[u] = 0u;
    __syncthreads();
    if (tid0 == 0) { LAS unsigned long long* cx = (LAS unsigned long long*)(ldsl + CTX_OFF);
#pragma unroll
        for (int i = 0; i < 23; ++i) cx[i] = (unsigned long long)(uintptr_t)args.in[i];
        cx[23] = (unsigned long long)(uintptr_t)args.out; cx[24] = (unsigned long long)(uintptr_t)args.ws; }
    __syncthreads();
    if (!MK_PER_PHASE) (void)xcd_barrier_post((unsigned*)(ctxp(ldsl, 24) + WS_CTL) + CW_BAR, MISC + 8, tid0 == 0);
    if (!MK_PER_PHASE && tid0 == 0) { const int c_ = blockIdx.x; __hip_atomic_store((gu32*)(ctxp(ldsl, 24) + WS_CTL) + CW_GRP + 64 * ((c_ & 7) * 8 + ((c_ >> 3) & 7)) + 8 + (c_ >> 6), xb_xcc_id() + 1u, RLX_AGENT); }
    const int lo = args.ph_lo, hi = args.ph_hi;
    int ph = 0, par = 0;
#define IN_() (lo <= ph && ph < hi)
#define SEAM() do { if (!MK_PER_PHASE && lo <= ph && ph + 1 < hi) { XcdBarrier b_; b_.bar = (unsigned*)(ctxp(ldsl, 24) + WS_CTL) + CW_BAR; b_.x = xb_xcc_id(); b_.st = MISC + 8; xcd_barrier(b_, LEADER()); } ++ph; } while (0)
#define WSP() ctxp(ldsl, 24)
    unsigned gk = 0u;
#define SEAM_G() do { if (!MK_PER_PHASE && lo <= ph && ph + 1 < hi) { int c_ = blockIdx.x; asm volatile("" : "+s"(c_)); ++gk; group_barrier((gu32*)(ctxp(ldsl, 24) + WS_CTL), (c_ & 7) * 8 + ((c_ >> 3) & 7), 4u * gk, MISC + 12, LEADER()); } ++ph; } while (0)

    if (IN_()) { PHASE_IDS(); p0_prologue(ldsl, wave, lane, G); }
    SEAM();

    for (int pr = 0; pr < 4 * DEPTH; ++pr) {
        const int l = pr >> 2, sub = pr & 3, kind = l % 3, jj = l / 3;
        if (sub != 3 && IN_()) {
            PHASE_IDS();
            unsigned char* ws = WSP(); bf16h* BIG = (bf16h*)(ws + WS_BIG); bf16h* OT = (bf16h*)(ws + WS_OT);
            const pg8::bf16_t* wl = (const pg8::bf16_t*)(ws + WS_W) + (size_t)l * WL_SIZE;
            const pg8::bf16_t* hb_cur = (const pg8::bf16_t*)(ws + (par ? WS_HB1 : WS_HB0));
            const float* ssq_cur = (const float*)(ws + (par ? WS_SSQ1 : WS_SSQ0));
            pg8::Gemm g; pg8::XEpi E; g.M = M; g.lda = DM; E.rs = rstab; E.use_rstd = 1; E.act = 0; E.nglu = 0; E.O1 = (pg8::bf16_t*)BIG; E.ld1 = NQ; E.O2 = (pg8::bf16_t*)BIG; E.ld2 = NQ;
            if (sub == 0 || sub == 2) { g.A = hb_cur; g.Bt = wl + (sub == 0 ? WL_FFN1_IN : WL_FFN2_IN); g.N = 2 * FF; g.K = DM; E.nglu = 2 * FF / 256; E.act = 1; }
            else if (sub == 1) { g.A = hb_cur; g.Bt = wl + WL_MIX_IN; g.K = DM;
                if (kind == 0) { g.N = NA; } else if (kind == 1) { g.N = NB; }
                else { g.N = NC; E.nglu = 16; E.O1 = (pg8::bf16_t*)OT; E.ld1 = DM; E.O2 = (pg8::bf16_t*)(OT + (size_t)M * DM); E.ld2 = DM; } }
            E.tssq = ssq_cur; E.tpm = my_pm; E.tw = rstab;
            const int ncall = sub == 2 ? 2 : 1;
            for (int call = 0; call < ncall; ++call) {
                if (call == 1) { g.A = (const pg8::bf16_t*)(ws + WS_PB) + (size_t)l * M * PLE; g.lda = PLE; g.Bt = wl + WL_PLE_P; g.N = DM; g.K = PLE; E.use_rstd = 0; E.tssq = nullptr; E.nglu = 0; E.O2 = (pg8::bf16_t*)(OT + (size_t)2 * M * DM); E.ld2 = DM; }
                pg8::PanelOrder S; S.init(g.N, G, cwg);
                pg8::gemm_phase<pg8::XEpi, pg8::PanelOrder, true, true>(ldsl + RING_OFF, g, S, E, tid);
            }
        }
        if (sub == 1) SEAM(); else if (sub != 3) SEAM_G();
        if (sub == 1) {
            if (kind == 0) {
                if (IN_()) {
                    PHASE_IDS();
                    unsigned char* ws = WSP(); const bf16h* BIG = (const bf16h*)(ws + WS_BIG); bf16h* OT = (bf16h*)(ws + WS_OT); float* LSE = (float*)(ws + WS_LSE);
                    swa::Seam S; swa::BlockRef cur = a_ref(0, cwg, BIG, OT, LSE), nxt;
                    swa::causal_swa_prime(cur, 129, (char*)lds + RING_OFF, (swa::lds_u8*)(ldsl + RING_OFF), S, wave_s);
                    asm volatile("s_cmp_lt_u32 %0, 4\n\ts_cbranch_scc1 .Lsp%=\n\ts_setprio 1\n.Lsp%=:" :: "s"(wave) : "scc");
                    for (int n = 0; n < 12; ++n) { nxt = (n < 11) ? a_ref(n + 1, cwg, BIG, OT, LSE) : cur; swa::causal_swa_block<true>(cur, nxt, 129, (char*)lds + RING_OFF, (swa::lds_u8*)(ldsl + RING_OFF), S, wave_s); cur = nxt; }
                    swa::causal_swa_finish();
                }
                SEAM();
                if (IN_()) {
                    PHASE_IDS();
                    unsigned char* ws = WSP(); const bf16h* OT = (const bf16h*)(ws + WS_OT); bf16h* AO = (bf16h*)(ws + WS_AO); const float* LSE = (const float*)(ws + WS_LSE);
                    for (int i = 0; i < 8; ++i) { const int m = my_pm * 256 + (cwg >> 6) * 64 + wave * 8 + i;
#pragma unroll
                        for (int j = 0; j < 4; ++j) { const int c = lane + 64 * j, head = c >> 4;
                            const float l0 = LSE[(size_t)m * 16 + head], l1 = LSE[(size_t)(M + m) * 16 + head], l2 = LSE[(size_t)(2 * M + m) * 16 + head];
                            const float mx = fmaxf(l0, fmaxf(l1, l2)); float w0 = __builtin_amdgcn_exp2f(l0 - mx), w1 = __builtin_amdgcn_exp2f(l1 - mx), w2 = __builtin_amdgcn_exp2f(l2 - mx);
                            const float inv = 1.0f / (w0 + w1 + w2); w0 *= inv; w1 *= inv; w2 *= inv;
                            const v4u a = *(const v4u*)(OT + (size_t)m * DM + 8 * c), b = *(const v4u*)(OT + (size_t)(M + m) * DM + 8 * c), d = *(const v4u*)(OT + (size_t)(2 * M + m) * DM + 8 * c);
                            v4u o;
                            o.x = cvtpk2(w0 * bflo(a.x) + w1 * bflo(b.x) + w2 * bflo(d.x), w0 * bfhi(a.x) + w1 * bfhi(b.x) + w2 * bfhi(d.x));
                            o.y = cvtpk2(w0 * bflo(a.y) + w1 * bflo(b.y) + w2 * bflo(d.y), w0 * bfhi(a.y) + w1 * bfhi(b.y) + w2 * bfhi(d.y));
                            o.z = cvtpk2(w0 * bflo(a.z) + w1 * bflo(b.z) + w2 * bflo(d.z), w0 * bfhi(a.z) + w1 * bfhi(b.z) + w2 * bfhi(d.z));
                            o.w = cvtpk2(w0 * bflo(a.w) + w1 * bflo(b.w) + w2 * bflo(d.w), w0 * bfhi(a.w) + w1 * bfhi(b.w) + w2 * bfhi(d.w));
                            *(v4u*)(AO + (size_t)m * DM + 8 * c) = o; }
                    }
                }
                SEAM_G();
            } else if (kind == 1) {
                if (IN_()) {
                    PHASE_IDS();
                    unsigned char* ws = WSP(); const bf16h* BIG = (const bf16h*)(ws + WS_BIG); bf16h* OT = (bf16h*)(ws + WS_OT);
                    if (wave >= 4) dattn_phase_upper(cwg, BIG, OT, (char*)lds + RING_OFF, (swa::lds_u8*)(ldsl + RING_OFF), wave_s); else dattn_phase_lower(cwg, BIG, OT, (char*)lds + RING_OFF, (swa::lds_u8*)(ldsl + RING_OFF), wave_s);
                    swa::causal_swa_finish();
                }
                SEAM();
                if (IN_()) {
                    PHASE_IDS();
                    unsigned char* ws = WSP(); const bf16h* OT = (const bf16h*)(ws + WS_OT); bf16h* AO = (bf16h*)(ws + WS_AO);
                    const float* lp = CTX_IN(10) + (size_t)jj * 4 * HD; const float* sg = CTX_IN(11) + (size_t)jj * 2 * HD;
                    float s1 = lp[lane] * lp[HD + lane] + lp[64 + lane] * lp[HD + 64 + lane], s2 = lp[2 * HD + lane] * lp[3 * HD + lane] + lp[2 * HD + 64 + lane] * lp[3 * HD + 64 + lane];
                    s1 = wave_sum(s1, lane); s2 = wave_sum(s2, lane);
                    const float lam_init = 0.8f - 0.6f * expf(-0.3f * (float)l), lam = expf(s1) - expf(s2) + lam_init, post = 1.0f - lam_init;
                    for (int i = 0; i < 8; ++i) { const int m = my_pm * 256 + (cwg >> 6) * 64 + wave * 8 + i;
#pragma unroll
                        for (int j = 0; j < 4; ++j) { const int oc = 8 * (lane + 64 * j), jc = oc & 255;
                            const v4u a = *(const v4u*)(OT + (size_t)m * DM + oc), b = *(const v4u*)(OT + (size_t)(M + m) * DM + oc);
                            float d[8]; d[0] = bflo(a.x) - lam * bflo(b.x); d[1] = bfhi(a.x) - lam * bfhi(b.x); d[2] = bflo(a.y) - lam * bflo(b.y); d[3] = bfhi(a.y) - lam * bfhi(b.y);
                            d[4] = bflo(a.z) - lam * bflo(b.z); d[5] = bfhi(a.z) - lam * bfhi(b.z); d[6] = bflo(a.w) - lam * bflo(b.w); d[7] = bfhi(a.w) - lam * bfhi(b.w);
                            float ss = (d[0] * d[0] + d[1] * d[1]) + (d[2] * d[2] + d[3] * d[3]) + (d[4] * d[4] + d[5] * d[5]) + (d[6] * d[6] + d[7] * d[7]);
                            ss += shx(ss, 1, lane); ss += shx(ss, 2, lane); ss += shx(ss, 4, lane); ss += shx(ss, 8, lane); ss += shx(ss, 16, lane);
                            const float r = post / sqrtf(ss * (1.0f / 256.0f) + SUBLN_EPS);
                            const f32x4 g0 = *(const f32x4*)(sg + jc), g1 = *(const f32x4*)(sg + jc + 4);
                            v4u o; o.x = cvtpk2(d[0] * r * g0.x, d[1] * r * g0.y); o.y = cvtpk2(d[2] * r * g0.z, d[3] * r * g0.w); o.z = cvtpk2(d[4] * r * g1.x, d[5] * r * g1.y); o.w = cvtpk2(d[6] * r * g1.z, d[7] * r * g1.w);
                            *(v4u*)(AO + (size_t)m * DM + oc) = o; }
                    }
                }
                SEAM_G();
            } else {
                if (IN_()) { PHASE_IDS();
                    unsigned char* ws = WSP(); const bf16h* OT = (const bf16h*)(ws + WS_OT); const bf16h* BIG = (const bf16h*)(ws + WS_BIG); bf16h* AO = (bf16h*)(ws + WS_AO);
                    const float* cw = CTX_IN(13) + (size_t)jj * 3 * DM;
                    for (int i = 0; i < 8; ++i) { const int m = my_pm * 256 + (cwg >> 6) * 64 + wave * 8 + i; const int t = m & (SEQ - 1);
#pragma unroll
                        for (int j = 0; j < 4; ++j) { const int col = 8 * (lane + 64 * j);
                            const v4u z0 = *(const v4u*)(OT + (size_t)m * DM + col); v4u z1 = {0u, 0u, 0u, 0u}, z2 = {0u, 0u, 0u, 0u};
                            if (t >= 1) z1 = *(const v4u*)(OT + (size_t)(m - 1) * DM + col);
                            if (t >= 2) z2 = *(const v4u*)(OT + (size_t)(m - 2) * DM + col);
                            const v4u bg = *(const v4u*)(OT + (size_t)(M + m) * DM + col);
                            const f32x4 wa0 = *(const f32x4*)(cw + col), wa1 = *(const f32x4*)(cw + col + 4), wb0 = *(const f32x4*)(cw + DM + col), wb1 = *(const f32x4*)(cw + DM + col + 4),
                                        wc0 = *(const f32x4*)(cw + 2 * DM + col), wc1 = *(const f32x4*)(cw + 2 * DM + col + 4);
                            v4u o;
                            o.x = cvtpk2(bflo(bg.x) * (wa0.x * bflo(z2.x) + wb0.x * bflo(z1.x) + wc0.x * bflo(z0.x)), bfhi(bg.x) * (wa0.y * bfhi(z2.x) + wb0.y * bfhi(z1.x) + wc0.y * bfhi(z0.x)));
                            o.y = cvtpk2(bflo(bg.y) * (wa0.z * bflo(z2.y) + wb0.z * bflo(z1.y) + wc0.z * bflo(z0.y)), bfhi(bg.y) * (wa0.w * bfhi(z2.y) + wb0.w * bfhi(z1.y) + wc0.w * bfhi(z0.y)));
                            o.z = cvtpk2(bflo(bg.z) * (wa1.x * bflo(z2.z) + wb1.x * bflo(z1.z) + wc1.x * bflo(z0.z)), bfhi(bg.z) * (wa1.y * bfhi(z2.z) + wb1.y * bfhi(z1.z) + wc1.y * bfhi(z0.z)));
                            o.w = cvtpk2(bflo(bg.w) * (wa1.z * bflo(z2.w) + wb1.z * bflo(z1.w) + wc1.z * bflo(z0.w)), bfhi(bg.w) * (wa1.w * bfhi(z2.w) + wb1.w * bfhi(z1.w) + wc1.w * bfhi(z0.w)));
                            *(v4u*)(AO + (size_t)m * DM + col) = o; }
                    }
                }
                SEAM_G();
            }
        }
        if (IN_()) {
            PHASE_IDS();
            unsigned char* ws = WSP(); const bf16h* BIG = (const bf16h*)(ws + WS_BIG); const bf16h* AO = (const bf16h*)(ws + WS_AO); const bf16h* OT = (const bf16h*)(ws + WS_OT);
            const pg8::bf16_t* wl = (const pg8::bf16_t*)(ws + WS_W) + (size_t)l * WL_SIZE;
            const pg8::bf16_t* hb_cur = (const pg8::bf16_t*)(ws + (par ? WS_HB1 : WS_HB0));
            const float* ssq_cur = (const float*)(ws + (par ? WS_SSQ1 : WS_SSQ0));
            pg8::Gemm g; pg8::REpi E; g.M = M; g.N = DM; g.lda = DM; E.H16 = (pg8::bf16_t*)(ws + WS_H16); E.HBin = hb_cur; E.rd16 = pr <= RES16_PAIRS ? 1 : 0; E.wr16 = pr < RES16_PAIRS ? 1 : 0; E.HB = (pg8::bf16_t*)(ws + (par ? WS_HB0 : WS_HB1)); E.SSQ = (float*)(ws + (par ? WS_SSQ0 : WS_SSQ1));
            E.scale = 1.f; E.mode = 0; E.PP = (const pg8::bf16_t*)(OT + (size_t)2 * M * DM); E.bias = CTX_IN(20) + (size_t)l * DM; E.rs = rstab;
            if (sub == 0 || sub == 2) { g.A = (const pg8::bf16_t*)BIG; g.lda = NQ; g.Bt = wl + (sub == 0 ? WL_FFN1_OUT : WL_FFN2_OUT); g.K = FF; E.scale = 0.5f; }
            else if (sub == 1) { g.A = (const pg8::bf16_t*)AO; g.Bt = wl + WL_MIX_OUT; g.K = DM; }
            else { g.A = hb_cur; g.Bt = wl + WL_PLE_G; g.K = DM; E.mode = 1; }
            E.tssq = E.mode ? ssq_cur : nullptr; E.tpm = my_pm; E.tw = rstab;
            pg8::PanelOrder S; S.init(DM, G, cwg);
            pg8::gemm_phase<pg8::REpi, pg8::PanelOrder, true, true>(ldsl + RING_OFF, g, S, E, tid);
        }
        par ^= 1;
        SEAM_G();
    }
    if (IN_()) {
        PHASE_IDS();
        unsigned char* ws = WSP(); const bf16h* HBf = (const bf16h*)(ws + (par ? WS_HB1 : WS_HB0)); float* outp = (float*)ctxp(ldsl, 23);
        const float* ssq = (const float*)(ws + (par ? WS_SSQ1 : WS_SSQ0)); const float* gf = CTX_IN(22);
        for (int i = 0; i < 8; ++i) { const int m = my_pm * 256 + (cwg >> 6) * 64 + wave * 8 + i;
            float s = lane < 32 ? ssq[((size_t)(lane >> 2) * M + m) * 4 + (lane & 3)] : 0.f; s = wave_sum(s, lane);
            const float rstd = 1.0f / sqrtf(s * (1.0f / DM) + RMS_EPS);
            GAS f32x4* orow = (GAS f32x4*)(outp + (size_t)m * DM); const f32x4* g4 = (const f32x4*)gf;
#pragma unroll
            for (int j = 0; j < 4; ++j) { const int c8 = lane + 64 * j;
                const v4u hw = *(const v4u*)(HBf + (size_t)m * DM + 8 * c8);
                const f32x4 ga = g4[2 * c8], gb = g4[2 * c8 + 1];
                orow[2 * c8] = (f32x4){bflo(hw.x) * rstd * ga.x, bfhi(hw.x) * rstd * ga.y, bflo(hw.y) * rstd * ga.z, bfhi(hw.y) * rstd * ga.w};
                orow[2 * c8 + 1] = (f32x4){bflo(hw.z) * rstd * gb.x, bfhi(hw.z) * rstd * gb.y, bflo(hw.w) * rstd * gb.z, bfhi(hw.w) * rstd * gb.w}; }
        }
    }
#undef IN_
#undef SEAM
#undef SEAM_G
#undef WSP
#undef PHASE_IDS
}

extern "C" void kernel_launch(void* const* d_in, const int* in_sizes, int n_in, void* d_out, int out_size, void* d_ws, size_t ws_size, hipStream_t stream) {
    static int grid = 0;
    if (grid == 0) {
        if (n_in != 23 || in_sizes[0] != M * DM || out_size != M * DM || ws_size < WS_END) {
            fprintf(stderr, "kernel_launch: built for 23 inputs, x/out of %d floats, >= %zu bytes of workspace; got n_in %d, in0 %d, out %d, ws %zu; nothing launched\n", M * DM, (size_t)WS_END, n_in, n_in > 0 ? in_sizes[0] : -1, out_size, ws_size); grid = -1; return; }
        int dev = 0, cus = 0, per_cu = 0;
        if (hipGetDevice(&dev) != hipSuccess || hipDeviceGetAttribute(&cus, hipDeviceAttributeMultiprocessorCount, dev) != hipSuccess) { fprintf(stderr, "kernel_launch: hipGetDevice / hipDeviceGetAttribute failed\n"); grid = -1; return; }
        if (hipFuncSetAttribute((const void*)mk_fwd, hipFuncAttributeMaxDynamicSharedMemorySize, LDS_BYTES) != hipSuccess) { fprintf(stderr, "kernel_launch: hipFuncSetAttribute failed\n"); grid = -1; return; }
        if (hipOccupancyMaxActiveBlocksPerMultiprocessor(&per_cu, (const void*)mk_fwd, NWAVES * 64, LDS_BYTES) != hipSuccess || per_cu < 1)
            fprintf(stderr, "kernel_launch: note: occupancy query reports %d workgroups per CU\n", per_cu);
        (void)hipGetLastError();
        grid = 256;
        if (cus < 256) { fprintf(stderr, "kernel_launch: device has %d CUs; this kernel needs 256 resident workgroups; nothing launched\n", cus); grid = -1; return; }
    }
    if (grid < 0) return;
    if (hipMemsetAsync((char*)d_ws + WS_CTL, 0, CTL_ZERO_BYTES, stream) != hipSuccess) { fprintf(stderr, "kernel_launch: hipMemsetAsync failed\n"); return; }
    Args a{};
    for (int i = 0; i < 23; ++i) a.in[i] = (const float*)d_in[i];
    a.out = (float*)d_out; a.ws = (unsigned char*)d_ws;
#if MK_PER_PHASE
    for (int li = 0; li < N_PHASES; ++li) { a.ph_lo = li; a.ph_hi = li + 1; hipLaunchKernelGGL(mk_fwd, dim3(grid), dim3(NWAVES * 64), LDS_BYTES, stream, a); }
#else
    a.ph_lo = 0; a.ph_hi = N_PHASES;
    hipLaunchKernelGGL(mk_fwd, dim3(grid), dim3(NWAVES * 64), LDS_BYTES, stream, a);
#endif
    const hipError_t le = hipPeekAtLastError();
    if (le != hipSuccess) fprintf(stderr, "kernel_launch: launch failed: %s\n", hipGetErrorName(le));
}
```
